# Optimizing an MI355X kernel written in HIP

```python
import math
import jax, jax.numpy as jnp
from jax import lax
import numpy as np

D_MODEL = 2048
BATCH = 4
SEQ = 2048
DEPTH = 1

CHUNK = 64
Q_BLOCK = 128

N_HEADS = 16
QK_NOPE = 128
QK_ROPE = 64
V_HEAD = 128
Q_LORA = 512
KV_LORA = 512
ROPE_THETA = 10000.0
ATTN_SCALE = (QK_NOPE + QK_ROPE) ** -0.5

CONV_WIDTH = D_MODEL
CONV_K = 3

D_FF = ((8 * D_MODEL + 3 * 256 - 1) // (3 * 256)) * 256

COL_Q_A = Q_LORA
COL_KV_A = KV_LORA
COL_K_ROPE = QK_ROPE
COL_CONV_B = CONV_WIDTH
COL_CONV_C = CONV_WIDTH
COL_CONV_X = CONV_WIDTH
COL_GATE_A = D_MODEL
COL_GATE_B = D_MODEL
D_IN_ALL = COL_Q_A + COL_KV_A + COL_K_ROPE + COL_CONV_B + COL_CONV_C + COL_CONV_X + COL_GATE_A + COL_GATE_B
SPLIT_POINTS = (
    COL_Q_A,
    COL_Q_A + COL_KV_A,
    COL_Q_A + COL_KV_A + COL_K_ROPE,
    COL_Q_A + COL_KV_A + COL_K_ROPE + COL_CONV_B,
    COL_Q_A + COL_KV_A + COL_K_ROPE + COL_CONV_B + COL_CONV_C,
    COL_Q_A + COL_KV_A + COL_K_ROPE + COL_CONV_B + COL_CONV_C + COL_CONV_X,
    COL_Q_A + COL_KV_A + COL_K_ROPE + COL_CONV_B + COL_CONV_C + COL_CONV_X + COL_GATE_A,
)

DEEPNORM_ALPHA = (2.0 * DEPTH) ** 0.25
DEEPNORM_BETA = (8.0 * DEPTH) ** -0.25
LN_EPS = 1e-5
RMS_EPS = 1e-6

kernel_name = "hybrid_mla_shortconv_swiglu_deepnorm_adaln"


def layer_norm(x, g, b):
    xf = x.astype(jnp.float32)
    mu = jnp.mean(xf, axis=-1, keepdims=True)
    var = jnp.mean(jnp.square(xf - mu), axis=-1, keepdims=True)
    y = (xf - mu) * lax.rsqrt(var + LN_EPS)
    return (y * g.astype(jnp.float32) + b.astype(jnp.float32)).astype(x.dtype)


def rms_norm(x, g):
    xf = x.astype(jnp.float32)
    y = xf * lax.rsqrt(jnp.mean(jnp.square(xf), axis=-1, keepdims=True) + RMS_EPS)
    return (y * g.astype(jnp.float32)).astype(x.dtype)


def rope_tables(positions):
    inv_freq = 1.0 / (ROPE_THETA ** (jnp.arange(0, QK_ROPE, 2, dtype=jnp.float32) / QK_ROPE))
    ang = positions.astype(jnp.float32)[..., None] * inv_freq
    return jnp.cos(ang), jnp.sin(ang)


def apply_rope(x, cos, sin):
    xf = x.astype(jnp.float32)
    x1, x2 = jnp.split(xf, 2, axis=-1)
    out = jnp.concatenate([x1 * cos - x2 * sin, x2 * cos + x1 * sin], axis=-1)
    return out.astype(x.dtype)


def chunk_causal_mla_attention(q_nope, q_rope, k_nope, k_rope, v):
    S = q_nope.shape[1]
    outs = []
    for i in range(S // Q_BLOCK):
        q0 = i * Q_BLOCK
        L = q0 + Q_BLOCK
        s = (jnp.einsum('bqhd,bkhd->bhqk', q_nope[:, q0:L], k_nope[:, :L])
             + jnp.einsum('bqhr,bkr->bhqk', q_rope[:, q0:L], k_rope[:, :L]))
        s = s.astype(jnp.float32) * ATTN_SCALE
        q_chunk = (q0 + jnp.arange(Q_BLOCK)) // CHUNK
        k_chunk = jnp.arange(L) // CHUNK
        allowed = k_chunk[None, :] <= q_chunk[:, None]
        s = jnp.where(allowed[None, None], s, jnp.float32(-1e30))
        p = jax.nn.softmax(s, axis=-1).astype(v.dtype)
        outs.append(jnp.einsum('bhqk,bkhd->bqhd', p, v[:, :L]))
    return jnp.concatenate(outs, axis=1)


def causal_depthwise_conv(z, w_conv):
    S = z.shape[1]
    zp = jnp.pad(z, ((0, 0), (CONV_K - 1, 0), (0, 0)))
    out = zp[:, 0:S] * w_conv[0]
    for k in range(1, CONV_K):
        out = out + zp[:, k:k + S] * w_conv[k]
    return out


def setup_inputs(seed: int = 0) -> dict:
    key = jax.random.key(seed)
    ks = jax.random.split(key, 24)
    f32 = jnp.float32

    def nrm(k, shape, scale):
        return jax.random.normal(k, shape, f32) * scale

    x = nrm(ks[0], (BATCH, SEQ, D_MODEL), 1.0)
    c = nrm(ks[1], (BATCH, D_MODEL), 1.0)
    offsets = jax.random.randint(ks[2], (BATCH, 1), 0, 64, dtype=jnp.int32) * CHUNK
    positions = (offsets + jnp.arange(SEQ, dtype=jnp.int32)[None, :]).astype(jnp.int32)

    inputs = {
        "x": x,
        "c": c,
        "positions": positions,
        "w_ada": nrm(ks[3], (DEPTH, D_MODEL, 6 * D_MODEL), 0.5 * D_MODEL ** -0.5),
        "b_ada": nrm(ks[4], (DEPTH, 6 * D_MODEL), 0.01),
        "w_in": nrm(ks[5], (DEPTH, D_MODEL, D_IN_ALL), D_MODEL ** -0.5),
        "g_q_a": 1.0 + nrm(ks[6], (DEPTH, Q_LORA), 0.02),
        "w_q_b": nrm(ks[7], (DEPTH, Q_LORA, N_HEADS * (QK_NOPE + QK_ROPE)), Q_LORA ** -0.5),
        "g_kv_a": 1.0 + nrm(ks[8], (DEPTH, KV_LORA), 0.02),
        "w_kv_b": nrm(ks[9], (DEPTH, KV_LORA, N_HEADS * (QK_NOPE + V_HEAD)), KV_LORA ** -0.5),
        "w_o_a": nrm(ks[10], (DEPTH, N_HEADS * V_HEAD, D_MODEL), (N_HEADS * V_HEAD) ** -0.5 * DEEPNORM_BETA),
        "w_conv": nrm(ks[11], (DEPTH, CONV_K, CONV_WIDTH), CONV_K ** -0.5),
        "w_o_b": nrm(ks[12], (DEPTH, CONV_WIDTH, D_MODEL), CONV_WIDTH ** -0.5 * DEEPNORM_BETA),
        "w_o": nrm(ks[13], (DEPTH, D_MODEL, D_MODEL), D_MODEL ** -0.5 * DEEPNORM_BETA),
        "ln1_g": 1.0 + nrm(ks[14], (DEPTH, D_MODEL), 0.02),
        "ln1_b": nrm(ks[15], (DEPTH, D_MODEL), 0.02),
        "w_ffn_in": nrm(ks[16], (DEPTH, D_MODEL, 2 * D_FF), D_MODEL ** -0.5),
        "w_ffn_out": nrm(ks[17], (DEPTH, D_FF, D_MODEL), D_FF ** -0.5 * DEEPNORM_BETA),
        "ln2_g": 1.0 + nrm(ks[18], (DEPTH, D_MODEL), 0.02),
        "ln2_b": nrm(ks[19], (DEPTH, D_MODEL), 0.02),
    }
    return inputs


def reference(x, c, positions, w_ada, b_ada, w_in, g_q_a, w_q_b, g_kv_a, w_kv_b, w_o_a,
              w_conv, w_o_b, w_o, ln1_g, ln1_b, w_ffn_in, w_ffn_out, ln2_g, ln2_b):
    B, S, D = x.shape
    cos, sin = rope_tables(positions)
    cos_q, sin_q = cos[:, :, None, :], sin[:, :, None, :]
    c_act = jax.nn.silu(c)

    for l in range(DEPTH):
        mod = c_act @ w_ada[l] + b_ada[l]
        shift1, scale1, gate1, shift2, scale2, gate2 = [m[:, None, :] for m in jnp.split(mod, 6, axis=-1)]

        u = x * (1.0 + scale1) + shift1
        proj = u @ w_in[l]
        q_a, kv_a, k_rope, conv_b, conv_c, conv_x, gate_a, gate_b = jnp.split(proj, SPLIT_POINTS, axis=-1)

        q = (rms_norm(q_a, g_q_a[l]) @ w_q_b[l]).reshape(B, S, N_HEADS, QK_NOPE + QK_ROPE)
        q_nope, q_rope = q[..., :QK_NOPE], apply_rope(q[..., QK_NOPE:], cos_q, sin_q)
        kv = (rms_norm(kv_a, g_kv_a[l]) @ w_kv_b[l]).reshape(B, S, N_HEADS, QK_NOPE + V_HEAD)
        k_nope, v = kv[..., :QK_NOPE], kv[..., QK_NOPE:]
        k_rope = apply_rope(k_rope, cos, sin)
        attn = chunk_causal_mla_attention(q_nope, q_rope, k_nope, k_rope, v)
        y_a = attn.reshape(B, S, N_HEADS * V_HEAD) @ w_o_a[l]

        z = conv_c * conv_x
        y_b = (conv_b * causal_depthwise_conv(z, w_conv[l])) @ w_o_b[l]

        merged = jax.nn.sigmoid(gate_a) * y_a + jax.nn.sigmoid(gate_b) * y_b
        mix_out = merged @ w_o[l]
        x = layer_norm(DEEPNORM_ALPHA * x + gate1 * mix_out, ln1_g[l], ln1_b[l])

        u2 = x * (1.0 + scale2) + shift2
        h_gate, h_up = jnp.split(u2 @ w_ffn_in[l], 2, axis=-1)
        ffn_out = (jax.nn.silu(h_gate) * h_up) @ w_ffn_out[l]
        x = layer_norm(DEEPNORM_ALPHA * x + gate2 * ffn_out, ln2_g[l], ln2_b[l])

    return x
```

```cpp
#include <hip/hip_runtime.h>
#include <cstdio>
#include <cstdint>
#include <cmath>

namespace cfg {
constexpr int D = 2048, BATCH = 4, SEQ = 2048, M = BATCH * SEQ;
constexpr int NH = 16, QL = 512, KVL = 512, DFF = 5632, DIN = 11328, NMOD = 6 * D;
constexpr int C_KR = 1024;
constexpr float ALPHA = 1.189207115002721f;
constexpr float LN_EPS = 1e-5f, RMS_EPS = 1e-6f;
constexpr float QS = 0.07216878364870322f * 1.4426950408889634f;
constexpr size_t MiB = 1u << 20;
constexpr size_t WS_CTL = 0, WS_MOD = 1 * MiB, WS_MODP = 2 * MiB, WS_COS = 5 * MiB, WS_SIN = 6 * MiB, WS_SSQ = 7 * MiB, WS_KROPE = 8 * MiB;
constexpr size_t WS_W = 16 * MiB;
constexpr size_t WS_A0 = 96 * MiB;
constexpr size_t WS_QA = 128 * MiB, WS_KVA = 136 * MiB;
constexpr size_t WS_CB = 144 * MiB, WS_CC = 176 * MiB, WS_CX = 208 * MiB;
constexpr size_t WS_SGA = 240 * MiB, WS_SGB = 272 * MiB;
constexpr size_t WS_Q = 304 * MiB;
constexpr size_t WS_KV = 352 * MiB;
constexpr size_t WS_END = 416 * MiB;
}
using namespace cfg;

typedef unsigned short bf16_t;
__device__ __forceinline__ unsigned f2bf(float f) { unsigned u = __builtin_bit_cast(unsigned, f); return (u + 0x7fffu + ((u >> 16) & 1u)) >> 16; }
__device__ __forceinline__ float bf2f(bf16_t v) { return __builtin_bit_cast(float, (unsigned)v << 16); }
__device__ __forceinline__ float sigmoidf_(float v) { return 1.f / (1.f + expf(-v)); }

__global__ void nv_mod(const float* __restrict__ c, const float* __restrict__ w_ada, const float* __restrict__ b_ada, float* __restrict__ mod) {
    const int idx = blockIdx.x * 256 + threadIdx.x; const int b = idx / NMOD, n = idx % NMOD;
    float acc = 0.f;
    for (int k = 0; k < D; ++k) { const float v = c[b * D + k]; acc += (v / (1.f + expf(-v))) * w_ada[(size_t)k * NMOD + n]; }
    mod[idx] = acc + b_ada[n];
}
__global__ void nv_rope(const int* __restrict__ pos, float* __restrict__ cs, float* __restrict__ sn) {
    const int idx = blockIdx.x * 256 + threadIdx.x; const int m = idx >> 5, i = idx & 31;
    const float inv = 1.0f / powf(10000.f, (float)(2 * i) / 64.f);
    const float ang = (float)pos[m] * inv;
    cs[idx] = cosf(ang); sn[idx] = sinf(ang);
}
__global__ void nv_u(const float* __restrict__ x, const float* __restrict__ mod, bf16_t* __restrict__ U) {
    const size_t idx = (size_t)blockIdx.x * 256 + threadIdx.x; const int m = (int)(idx / D), d = (int)(idx % D), b = m / SEQ;
    const float sh = mod[b * NMOD + d], sc = mod[b * NMOD + D + d];
    U[idx] = (bf16_t)f2bf(x[idx] * (1.f + sc) + sh);
}
template <class Epi>
__global__ __launch_bounds__(256) void nv_gemm(const bf16_t* __restrict__ A1, const bf16_t* __restrict__ A2, int lda, const float* __restrict__ W1, const float* __restrict__ W2, int ldw,
                                                const float* __restrict__ ks, int K, Epi epi) {
    __shared__ float As1[16][68], As2[16][68], Bs1[16][68], Bs2[16][68];
    const int tid = threadIdx.x, m0 = blockIdx.y * 64, n0 = blockIdx.x * 64;
    const int ar = tid >> 2, ac = (tid & 3) * 4, bk = tid >> 4, bn = (tid & 15) * 4, ty = tid >> 4, tx = tid & 15;
    const int wc1 = epi.wcol1(n0 + (bn & ~31)) + (bn & 31);
    const int wc2 = Epi::DUAL_W ? epi.wcol2(n0 + (bn & ~31)) + (bn & 31) : 0;
    float c1[4][4], c2[4][4];
#pragma unroll
    for (int i = 0; i < 4; ++i)
#pragma unroll
        for (int j = 0; j < 4; ++j) { c1[i][j] = 0.f; c2[i][j] = 0.f; }
    for (int k0 = 0; k0 < K; k0 += 16) {
        { const bf16_t* p = A1 + (size_t)(m0 + ar) * lda + k0 + ac;
#pragma unroll
          for (int j = 0; j < 4; ++j) As1[ac + j][ar] = bf2f(p[j]);
          if (Epi::DUAL_A) { const bf16_t* p2 = A2 + (size_t)(m0 + ar) * lda + k0 + ac;
#pragma unroll
              for (int j = 0; j < 4; ++j) As2[ac + j][ar] = bf2f(p2[j]); } }
        { const float s = ks ? ks[k0 + bk] : 1.f; const float* p = W1 + (size_t)(k0 + bk) * ldw + wc1;
#pragma unroll
          for (int j = 0; j < 4; ++j) Bs1[bk][bn + j] = p[j] * s;
          if (Epi::DUAL_W) { const float* p2 = W2 + (size_t)(k0 + bk) * ldw + wc2;
#pragma unroll
              for (int j = 0; j < 4; ++j) Bs2[bk][bn + j] = p2[j] * s; } }
        __syncthreads();
#pragma unroll
        for (int kk = 0; kk < 16; ++kk) {
            float a1[4], a2[4], b1[4], b2[4];
#pragma unroll
            for (int i = 0; i < 4; ++i) { a1[i] = As1[kk][ty * 4 + i]; a2[i] = Epi::DUAL_A ? As2[kk][ty * 4 + i] : a1[i]; }
#pragma unroll
            for (int j = 0; j < 4; ++j) { b1[j] = Bs1[kk][tx * 4 + j]; b2[j] = Epi::DUAL_W ? Bs2[kk][tx * 4 + j] : 0.f; }
#pragma unroll
            for (int i = 0; i < 4; ++i)
#pragma unroll
                for (int j = 0; j < 4; ++j) { c1[i][j] += a1[i] * b1[j]; if (Epi::DUAL_W) c2[i][j] += a2[i] * b2[j]; }
        }
        __syncthreads();
    }
#pragma unroll
    for (int i = 0; i < 4; ++i)
#pragma unroll
        for (int j = 0; j < 4; ++j) epi(m0 + ty * 4 + i, n0 + tx * 4 + j, c1[i][j], c2[i][j]);
}
struct EpProj {
    static constexpr bool DUAL_W = false, DUAL_A = false;
    bf16_t *qa, *kva, *cb, *cc, *cx, *sga, *sgb;
    __device__ int wcol1(int n) const { return n < 1024 ? n : n + 64; }
    __device__ int wcol2(int) const { return 0; }
    __device__ void operator()(int m, int n, float v, float) const {
        if (n < 512) qa[(size_t)m * 512 + n] = (bf16_t)f2bf(v);
        else if (n < 1024) kva[(size_t)m * 512 + n - 512] = (bf16_t)f2bf(v);
        else if (n < 3072) cb[(size_t)m * D + n - 1024] = (bf16_t)f2bf(v);
        else if (n < 5120) cc[(size_t)m * D + n - 3072] = (bf16_t)f2bf(v);
        else if (n < 7168) cx[(size_t)m * D + n - 5120] = (bf16_t)f2bf(v);
        else if (n < 9216) sga[(size_t)m * D + n - 7168] = (bf16_t)f2bf(sigmoidf_(v));
        else sgb[(size_t)m * D + n - 9216] = (bf16_t)f2bf(sigmoidf_(v));
    }
};
struct EpKrope {
    static constexpr bool DUAL_W = true, DUAL_A = false;
    bf16_t* kr; const float *cs, *sn;
    __device__ int wcol1(int n) const { return C_KR + n; }
    __device__ int wcol2(int n) const { return C_KR + 32 + n; }
    __device__ void operator()(int m, int n, float v1, float v2) const {
        if (n >= 32) return;
        const float c = cs[m * 32 + n], s = sn[m * 32 + n];
        kr[(size_t)m * 64 + n] = (bf16_t)f2bf(v1 * c - v2 * s); kr[(size_t)m * 64 + 32 + n] = (bf16_t)f2bf(v2 * c + v1 * s);
    }
};
__global__ void nv_ssq(const bf16_t* __restrict__ qa, const bf16_t* __restrict__ kva, float* __restrict__ ssq) {
    const int m = blockIdx.x * 256 + threadIdx.x; float s1 = 0.f, s2 = 0.f;
    for (int k = 0; k < 512; ++k) { const float a = bf2f(qa[(size_t)m * 512 + k]), b = bf2f(kva[(size_t)m * 512 + k]); s1 += a * a; s2 += b * b; }
    for (int j = 0; j < 16; ++j) ssq[m * 16 + j] = 0.f;
    ssq[m * 16 + 0] = s1; ssq[m * 16 + 8] = s2;
}
__device__ __forceinline__ float rs_from_ssq(const float* ssq, int m, int which) {
    float s = 0.f;
#pragma unroll
    for (int j = 0; j < 8; ++j) s += ssq[m * 16 + which * 8 + j];
    return 1.0f / sqrtf(s * (1.f / 512.f) + RMS_EPS);
}
struct EpQnope {
    static constexpr bool DUAL_W = false, DUAL_A = false;
    bf16_t* Q; const float* ssq;
    __device__ int wcol1(int n) const { return (n >> 7) * 192 + (n & 127); }
    __device__ int wcol2(int) const { return 0; }
    __device__ void operator()(int m, int n, float v, float) const { Q[(size_t)m * 3072 + n] = (bf16_t)f2bf(v * rs_from_ssq(ssq, m, 0) * QS); }
};
struct EpQrope {
    static constexpr bool DUAL_W = true, DUAL_A = false;
    bf16_t* Q; const float *ssq, *cs, *sn;
    __device__ int wcol1(int n) const { return (n >> 5) * 192 + 128 + (n & 31); }
    __device__ int wcol2(int n) const { return (n >> 5) * 192 + 160 + (n & 31); }
    __device__ void operator()(int m, int n, float v1, float v2) const {
        const int h = n >> 5, i = n & 31; const float r = rs_from_ssq(ssq, m, 0) * QS; v1 *= r; v2 *= r;
        const float c = cs[m * 32 + i], s = sn[m * 32 + i];
        Q[(size_t)m * 3072 + 2048 + h * 64 + i] = (bf16_t)f2bf(v1 * c - v2 * s); Q[(size_t)m * 3072 + 2048 + h * 64 + 32 + i] = (bf16_t)f2bf(v2 * c + v1 * s);
    }
};
struct EpKV {
    static constexpr bool DUAL_W = false, DUAL_A = false;
    bf16_t* KV; const float* ssq;
    __device__ int wcol1(int n) const { return n; }
    __device__ int wcol2(int) const { return 0; }
    __device__ void operator()(int m, int n, float v, float) const { KV[(size_t)m * 4096 + n] = (bf16_t)f2bf(v * rs_from_ssq(ssq, m, 1)); }
};
struct EpMerge {
    static constexpr bool DUAL_W = true, DUAL_A = true;
    bf16_t* MG; const bf16_t *sga, *sgb;
    __device__ int wcol1(int n) const { return n; }
    __device__ int wcol2(int n) const { return n; }
    __device__ void operator()(int m, int n, float v1, float v2) const { const size_t o = (size_t)m * D + n; MG[o] = (bf16_t)f2bf(bf2f(sga[o]) * v1 + bf2f(sgb[o]) * v2); }
};
struct EpPre {
    static constexpr bool DUAL_W = false, DUAL_A = false;
    const float* base; float* out; const float* gate;
    __device__ int wcol1(int n) const { return n; }
    __device__ int wcol2(int) const { return 0; }
    __device__ void operator()(int m, int n, float v, float) const { const size_t o = (size_t)m * D + n; out[o] = ALPHA * base[o] + gate[(m / SEQ) * NMOD + n] * v; }
};
struct EpAct {
    static constexpr bool DUAL_W = true, DUAL_A = false;
    bf16_t* ACT;
    __device__ int wcol1(int n) const { return n; }
    __device__ int wcol2(int n) const { return DFF + n; }
    __device__ void operator()(int m, int n, float v1, float v2) const { ACT[(size_t)m * DFF + n] = (bf16_t)f2bf((v1 / (1.f + expf(-v1))) * v2); }
};
__global__ void nv_conv(const bf16_t* __restrict__ cb, const bf16_t* __restrict__ cc, const bf16_t* __restrict__ cx, const float* __restrict__ wconv, bf16_t* __restrict__ Y) {
    const size_t idx = (size_t)blockIdx.x * 256 + threadIdx.x; const int m = (int)(idx / D), c = (int)(idx % D), t = m % SEQ;
    float acc = 0.f;
#pragma unroll
    for (int k = 0; k < 3; ++k) { const int tt = t - 2 + k; if (tt >= 0) { const size_t o = idx - (size_t)(2 - k) * D; acc += wconv[k * D + c] * (bf2f(cc[o]) * bf2f(cx[o])); } }
    Y[idx] = (bf16_t)f2bf(bf2f(cb[idx]) * acc);
}
__global__ __launch_bounds__(256) void nv_attn(const bf16_t* __restrict__ Q, const bf16_t* __restrict__ KV, const bf16_t* __restrict__ KR, bf16_t* __restrict__ O) {
    __shared__ float sc[SEQ]; __shared__ float qv[192]; __shared__ float red[256]; __shared__ float part[256];
    const int tid = threadIdx.x; const int q = blockIdx.x % SEQ, h = (blockIdx.x / SEQ) % NH, b = blockIdx.x / (SEQ * NH);
    const int m = b * SEQ + q, L = (q / 64 + 1) * 64;
    if (tid < 128) qv[tid] = bf2f(Q[(size_t)m * 3072 + h * 128 + tid]); else if (tid < 192) qv[tid] = bf2f(Q[(size_t)m * 3072 + 2048 + h * 64 + tid - 128]);
    __syncthreads();
    float mx = -1e30f;
    for (int k = tid; k < L; k += 256) { const size_t mk = (size_t)(b * SEQ + k); float s = 0.f;
        for (int d = 0; d < 128; ++d) s += qv[d] * bf2f(KV[mk * 4096 + h * 256 + d]);
        for (int d = 0; d < 64; ++d) s += qv[128 + d] * bf2f(KR[mk * 64 + d]);
        sc[k] = s; mx = fmaxf(mx, s); }
    red[tid] = mx; __syncthreads();
    for (int o = 128; o > 0; o >>= 1) { if (tid < o) red[tid] = fmaxf(red[tid], red[tid + o]); __syncthreads(); }
    mx = red[0]; __syncthreads();
    float sum = 0.f;
    for (int k = tid; k < L; k += 256) { const float p = exp2f(sc[k] - mx); sc[k] = p; sum += p; }
    red[tid] = sum; __syncthreads();
    for (int o = 128; o > 0; o >>= 1) { if (tid < o) red[tid] += red[tid + o]; __syncthreads(); }
    sum = red[0];
    const int d = tid & 127, half = tid >> 7; float acc = 0.f;
    for (int k = half; k < L; k += 2) acc += sc[k] * bf2f(KV[(size_t)(b * SEQ + k) * 4096 + h * 256 + 128 + d]);
    part[tid] = acc; __syncthreads();
    if (tid < 128) O[(size_t)m * D + h * 128 + tid] = (bf16_t)f2bf((part[tid] + part[tid + 128]) / sum);
}
__global__ __launch_bounds__(256) void nv_ln(float* __restrict__ io, const float* __restrict__ g, const float* __restrict__ bta, const float* __restrict__ mod, bf16_t* __restrict__ U2) {
    __shared__ float red[256];
    const int tid = threadIdx.x, m = blockIdx.x, b = m / SEQ; float v[8]; float s = 0.f;
#pragma unroll
    for (int j = 0; j < 8; ++j) { v[j] = io[(size_t)m * D + j * 256 + tid]; s += v[j]; }
    red[tid] = s; __syncthreads();
    for (int o = 128; o > 0; o >>= 1) { if (tid < o) red[tid] += red[tid + o]; __syncthreads(); }
    const float mu = red[0] * (1.f / D); __syncthreads();
    float s2 = 0.f;
#pragma unroll
    for (int j = 0; j < 8; ++j) { v[j] -= mu; s2 += v[j] * v[j]; }
    red[tid] = s2; __syncthreads();
    for (int o = 128; o > 0; o >>= 1) { if (tid < o) red[tid] += red[tid + o]; __syncthreads(); }
    const float rstd = 1.0f / sqrtf(red[0] * (1.f / D) + LN_EPS);
#pragma unroll
    for (int j = 0; j < 8; ++j) { const int d = j * 256 + tid; const float y = v[j] * rstd * g[d] + bta[d]; io[(size_t)m * D + d] = y;
        if (U2) U2[(size_t)m * D + d] = (bf16_t)f2bf(y * (1.f + mod[b * NMOD + 4 * D + d]) + mod[b * NMOD + 3 * D + d]); }
}

namespace pg8 {
#define PG8_LAS __attribute__((address_space(3)))
typedef short bf16x8 __attribute__((ext_vector_type(8)));
typedef float f32x4 __attribute__((ext_vector_type(4)));
typedef unsigned u32x4 __attribute__((ext_vector_type(4)));
constexpr int BM = 256, BK = 64, HALF = 128, HTB = HALF * BK * 2  , STAGE_BYTES = 8 * HTB, NXCD = 8, WGM = 8;
__host__ __device__ __forceinline__ int lds_byte(int r, int c) { const int st = (r >> 4) * 2 + (c >> 5), rr = r & 15, cc = c & 31, ob = rr * 64 + cc * 2; return st * 1024 + (ob ^ (((ob >> 9) & 1) << 5)); }
__host__ __device__ __forceinline__ void stage_rc(int b, int& R, int& C) { const int st = b / 1024, sb = b % 1024, swz = sb ^ (((sb >> 9) & 1) << 5); R = (st >> 1) * 16 + swz / 64; C = (st & 1) * 32 + (swz % 64) / 2; }
__host__ __device__ __forceinline__ int perm32(int rho) { const int n = rho >> 4, i = rho & 15; return 8 * (i >> 2) + 4 * n + (i & 3); }

struct Unit { int pm, pn, flag; const char* A; const char* B; };
struct Sched {
    int kind, nM, nN, nwg, G, c; const char *A0, *A1, *B0, *B1; size_t a_tile, b_tile;
    __device__ __forceinline__ bool next(int i, Unit& u) const {
        int L, flag = 0;
        if (kind == 2) { L = (i >> 1) * G + c; flag = i & 1; } else L = i * G + c;
        if (L >= nwg) return false;
        int wgid = L; { const int q = nwg / NXCD, r = nwg % NXCD, xcd = wgid % NXCD, off = wgid / NXCD; wgid = (xcd < r ? xcd * (q + 1) : r * (q + 1) + (xcd - r) * q) + off; }
        const int nig = WGM * nN, gid = wgid / nig, fm = gid * WGM, gsz = (nM - fm) < WGM ? (nM - fm) : WGM;
        const int pm = fm + ((wgid % nig) % gsz), pn = (wgid % nig) / gsz;
        u.pm = pm; u.pn = pn; u.flag = flag;
        if (kind == 0) { u.A = A0 + (size_t)pm * a_tile; u.B = B0 + (size_t)pn * b_tile; }
        else if (kind == 1) { u.A = (pn < 16 ? A0 : A1) + (size_t)pm * a_tile; u.B = B0 + (size_t)pn * b_tile; }
        else { u.A = (flag ? A1 : A0) + (size_t)pm * a_tile; u.B = (flag ? B1 : B0) + (size_t)pn * b_tile; }
        return true;
    }
};
__device__ __forceinline__ unsigned cvt_pk_bf16(float lo, float hi) { unsigned r; asm volatile("v_cvt_pk_bf16_f32 %0, %1, %2" : "=v"(r) : "v"(lo), "v"(hi)); return r; }
__device__ __forceinline__ u32x4 pack8(f32x4 a, f32x4 b) { u32x4 w; w.x = cvt_pk_bf16(a[0], a[1]); w.y = cvt_pk_bf16(a[2], a[3]); w.z = cvt_pk_bf16(b[0], b[1]); w.w = cvt_pk_bf16(b[2], b[3]); return w; }
__device__ __forceinline__ void unpack8(u32x4 w, f32x4& a, f32x4& b) {
    a[0] = __builtin_bit_cast(float, w.x << 16); a[1] = __builtin_bit_cast(float, w.x & 0xffff0000u); a[2] = __builtin_bit_cast(float, w.y << 16); a[3] = __builtin_bit_cast(float, w.y & 0xffff0000u);
    b[0] = __builtin_bit_cast(float, w.z << 16); b[1] = __builtin_bit_cast(float, w.z & 0xffff0000u); b[2] = __builtin_bit_cast(float, w.w << 16); b[3] = __builtin_bit_cast(float, w.w & 0xffff0000u); }
__device__ __forceinline__ float fsig(float v) { return __builtin_amdgcn_rcpf(1.f + __builtin_amdgcn_exp2f(-1.4426950408889634f * v)); }
__device__ __forceinline__ f32x4 fsig4(f32x4 v) { f32x4 r; r[0] = fsig(v[0]); r[1] = fsig(v[1]); r[2] = fsig(v[2]); r[3] = fsig(v[3]); return r; }

struct EpiProj {
    static constexpr bool PERM = true;
    bf16_t *QA, *KVA, *CB, *SG, *KR; float* SSQ; const float *COS, *SIN;
    __device__ __forceinline__ void operator()(const f32x4 (&acc)[2][2][4][2], const Unit& u, int wr, int wc, int fr, int fq) const {
        const int pn = u.pn, row0 = u.pm * BM + wr * 64 + fr, cw = wc * 32 + 8 * fq;
        if (pn < 44) {
            bf16_t* base; int ldc, col0; const bool sig = pn >= 28, stat = pn < 4;
            if (pn < 4) { base = pn < 2 ? QA : KVA; ldc = 512; col0 = (pn & 1) * 256; }
            else if (pn < 28) { const int t = pn - 4; base = CB + (size_t)(t >> 3) * ((size_t)M * D); ldc = D; col0 = (t & 7) * 256; }
            else { const int t = pn - 28; base = SG + (size_t)(t >> 3) * ((size_t)M * D); ldc = D; col0 = (t & 7) * 256; }
#pragma unroll
            for (int ai = 0; ai < 2; ++ai)
#pragma unroll
                for (int m = 0; m < 4; ++m) { const int row = row0 + ai * HALF + m * 16; bf16_t* rowp = base + (size_t)row * ldc + col0 + cw; float ss = 0.f;
#pragma unroll
                    for (int bj = 0; bj < 2; ++bj) { f32x4 v0 = acc[ai][bj][m][0], v1 = acc[ai][bj][m][1];
                        if (stat) ss += (v0[0] * v0[0] + v0[1] * v0[1]) + (v0[2] * v0[2] + v0[3] * v0[3]) + (v1[0] * v1[0] + v1[1] * v1[1]) + (v1[2] * v1[2] + v1[3] * v1[3]);
                        if (sig) { v0 = fsig4(v0); v1 = fsig4(v1); }
                        *(u32x4*)(rowp + bj * HALF) = pack8(v0, v1); }
                    if (stat) { ss += __shfl_xor(ss, 16); ss += __shfl_xor(ss, 32); if (fq == 0) SSQ[row * 16 + pn * 4 + wc] = ss; } }
        } else if (wc == 0) {
#pragma unroll
            for (int ai = 0; ai < 2; ++ai)
#pragma unroll
                for (int m = 0; m < 4; ++m) { const int row = row0 + ai * HALF + m * 16;
                    const f32x4 c0 = *(const f32x4*)(COS + row * 32 + 8 * fq), c1 = *(const f32x4*)(COS + row * 32 + 8 * fq + 4), s0 = *(const f32x4*)(SIN + row * 32 + 8 * fq), s1 = *(const f32x4*)(SIN + row * 32 + 8 * fq + 4);
                    const f32x4 a0 = acc[ai][0][m][0], a1 = acc[ai][0][m][1], b0 = acc[ai][1][m][0], b1 = acc[ai][1][m][1];
                    *(u32x4*)(KR + (size_t)row * 64 + 8 * fq) = pack8(a0 * c0 - b0 * s0, a1 * c1 - b1 * s1);
                    *(u32x4*)(KR + (size_t)row * 64 + 32 + 8 * fq) = pack8(b0 * c0 + a0 * s0, b1 * c1 + a1 * s1); }
        }
    }
};
__device__ __forceinline__ float row_rs(const float* SSQ, int row, int which) {
    const f32x4 a = *(const f32x4*)(SSQ + row * 16 + which * 8), b = *(const f32x4*)(SSQ + row * 16 + which * 8 + 4);
    const float s = ((a[0] + a[1]) + (a[2] + a[3])) + ((b[0] + b[1]) + (b[2] + b[3]));
    return 1.0f / sqrtf(s * (1.f / 512.f) + RMS_EPS);
}
struct EpiQKV {
    static constexpr bool PERM = true;
    bf16_t *KV, *Q; const float *SSQ, *COS, *SIN;
    __device__ __forceinline__ void operator()(const f32x4 (&acc)[2][2][4][2], const Unit& u, int wr, int wc, int fr, int fq) const {
        const int pn = u.pn, row0 = u.pm * BM + wr * 64 + fr, cw = wc * 32 + 8 * fq;
#pragma unroll
        for (int ai = 0; ai < 2; ++ai)
#pragma unroll
            for (int m = 0; m < 4; ++m) { const int row = row0 + ai * HALF + m * 16;
                if (pn < 24) {
                    const float rs = pn < 16 ? row_rs(SSQ, row, 1) : row_rs(SSQ, row, 0) * QS;
                    bf16_t* rowp = pn < 16 ? KV + (size_t)row * 4096 + pn * 256 + cw : Q + (size_t)row * 3072 + (pn - 16) * 256 + cw;
#pragma unroll
                    for (int bj = 0; bj < 2; ++bj) *(u32x4*)(rowp + bj * HALF) = pack8(acc[ai][bj][m][0] * rs, acc[ai][bj][m][1] * rs);
                } else {
                    const float rs = row_rs(SSQ, row, 0) * QS; const int head = 4 * (pn - 24) + wc;
                    const f32x4 c0 = *(const f32x4*)(COS + row * 32 + 8 * fq), c1 = *(const f32x4*)(COS + row * 32 + 8 * fq + 4), s0 = *(const f32x4*)(SIN + row * 32 + 8 * fq), s1 = *(const f32x4*)(SIN + row * 32 + 8 * fq + 4);
                    const f32x4 a0 = acc[ai][0][m][0] * rs, a1 = acc[ai][0][m][1] * rs, b0 = acc[ai][1][m][0] * rs, b1 = acc[ai][1][m][1] * rs;
                    bf16_t* rowp = Q + (size_t)row * 3072 + 2048 + head * 64 + 8 * fq;
                    *(u32x4*)(rowp) = pack8(a0 * c0 - b0 * s0, a1 * c1 - b1 * s1);
                    *(u32x4*)(rowp + 32) = pack8(b0 * c0 + a0 * s0, b1 * c1 + a1 * s1);
                } }
    }
};
struct EpiMerge {
    static constexpr bool PERM = true;
    bf16_t* MG; const bf16_t* SG;
    __device__ __forceinline__ void operator()(const f32x4 (&acc)[2][2][4][2], const Unit& u, int wr, int wc, int fr, int fq) const {
        const int row0 = u.pm * BM + wr * 64 + fr, col0 = u.pn * BM + wc * 32 + 8 * fq; const bf16_t* sg = SG + (u.flag ? (size_t)M * D : 0);
#pragma unroll
        for (int ai = 0; ai < 2; ++ai)
#pragma unroll
            for (int m = 0; m < 4; ++m) { const size_t off = (size_t)(row0 + ai * HALF + m * 16) * D + col0;
#pragma unroll
                for (int bj = 0; bj < 2; ++bj) { f32x4 g0, g1; unpack8(*(const u32x4*)(sg + off + bj * HALF), g0, g1);
                    f32x4 v0 = acc[ai][bj][m][0] * g0, v1 = acc[ai][bj][m][1] * g1;
                    if (u.flag) { f32x4 p0, p1; unpack8(*(const u32x4*)(MG + off + bj * HALF), p0, p1); v0 += p0; v1 += p1; }
                    *(u32x4*)(MG + off + bj * HALF) = pack8(v0, v1); } }
    }
};
struct EpiPre {
    static constexpr bool PERM = false;
    const float* base; float* out; const float* gate;
    __device__ __forceinline__ void operator()(const f32x4 (&acc)[2][2][4][2], const Unit& u, int wr, int wc, int fr, int fq) const {
        const int row0 = u.pm * BM + wr * 64 + fr, col0 = u.pn * BM + wc * 32 + 4 * fq; const float* gr = gate + (size_t)((u.pm * BM) / SEQ) * NMOD + col0;
        f32x4 gv[2][2];
#pragma unroll
        for (int bj = 0; bj < 2; ++bj)
#pragma unroll
            for (int n = 0; n < 2; ++n) gv[bj][n] = *(const f32x4*)(gr + bj * HALF + n * 16);
#pragma unroll
        for (int ai = 0; ai < 2; ++ai)
#pragma unroll
            for (int m = 0; m < 4; ++m) { const size_t off = (size_t)(row0 + ai * HALF + m * 16) * D + col0;
#pragma unroll
                for (int bj = 0; bj < 2; ++bj)
#pragma unroll
                    for (int n = 0; n < 2; ++n) { const f32x4 bs = *(const f32x4*)(base + off + bj * HALF + n * 16); *(f32x4*)(out + off + bj * HALF + n * 16) = bs * ALPHA + gv[bj][n] * acc[ai][bj][m][n]; }
                if (m & 1) asm volatile("" ::: "memory"); }
    }
};
struct EpiAct {
    static constexpr bool PERM = true;
    bf16_t* ACT;
    __device__ __forceinline__ void operator()(const f32x4 (&acc)[2][2][4][2], const Unit& u, int wr, int wc, int fr, int fq) const {
        const int row0 = u.pm * BM + wr * 64 + fr, col0 = u.pn * HALF + wc * 32 + 8 * fq;
#pragma unroll
        for (int ai = 0; ai < 2; ++ai)
#pragma unroll
            for (int m = 0; m < 4; ++m) { const f32x4 g0 = acc[ai][0][m][0], g1 = acc[ai][0][m][1];
                *(u32x4*)(ACT + (size_t)(row0 + ai * HALF + m * 16) * DFF + col0) = pack8(g0 * fsig4(g0) * acc[ai][1][m][0], g1 * fsig4(g1) * acc[ai][1][m][1]); }
    }
};

template <class Epi, bool ALIGN_EPI>
__device__ __forceinline__ void gemm_phase(PG8_LAS unsigned char* lds, const int K, const int lda, const int ldb, const Sched& S, const Epi& E) {
    const int tid = threadIdx.x, wid = __builtin_amdgcn_readfirstlane(tid >> 6), lane = tid & 63, wr = wid >> 2, wc = wid & 3, fr = lane & 15, fq = lane >> 4;
    const int nt = K / BK;
    unsigned voffA[2], voffB[2];
#pragma unroll
    for (int i = 0; i < 2; ++i) { int R, C; stage_rc(tid * 16 + i * 8192, R, C); const int Rb = Epi::PERM ? ((R & ~31) + perm32(R & 31)) : R;
        voffA[i] = (unsigned)(R * lda + C) * 2u; voffB[i] = (unsigned)(Rb * ldb + C) * 2u; }
    const size_t kstep = (size_t)(BK * 2);
    const size_t hstepA = (size_t)HALF * lda * 2, hstepB = (size_t)HALF * ldb * 2;
    const unsigned ldsw = (unsigned)wid * 1024u;
    const int aoff = lds_byte(wr * 64 + fr, fq * 8), boff = lds_byte(wc * 32 + fr, fq * 8);
#define PG8_SA(b, h) (((b) * 2 + (h)) * HTB)
#define PG8_SB(b, h) ((4 + (b) * 2 + (h)) * HTB)
#define PG8_STAGE(bufoff, gbase, voff) do { _Pragma("unroll") for (int _i = 0; _i < 2; ++_i) \
        __builtin_amdgcn_global_load_lds((const unsigned*)((const char*)(gbase) + (voff)[_i]), (PG8_LAS unsigned*)(lds + (bufoff) + ldsw + _i * 8192), 16, 0, 0); } while (0)
#define PG8_LDA(dst, b, h) do { _Pragma("unroll") for (int m = 0; m < 4; ++m) _Pragma("unroll") for (int k = 0; k < 2; ++k) dst[m][k] = *(const PG8_LAS bf16x8*)(lds + PG8_SA(b, h) + aoff + m * 2048 + k * 1024); } while (0)
#define PG8_LDB(dst, b, h) do { _Pragma("unroll") for (int n = 0; n < 2; ++n) _Pragma("unroll") for (int k = 0; k < 2; ++k) dst[n][k] = *(const PG8_LAS bf16x8*)(lds + PG8_SB(b, h) + boff + n * 2048 + k * 1024); } while (0)
#define PG8_MMA(ai, bj, At, Bt) do { __builtin_amdgcn_s_setprio(1); _Pragma("unroll") for (int m = 0; m < 4; ++m) _Pragma("unroll") for (int n = 0; n < 2; ++n) _Pragma("unroll") for (int k = 0; k < 2; ++k) \
        acc[ai][bj][m][n] = __builtin_amdgcn_mfma_f32_16x16x32_bf16(Bt[n][k], At[m][k], acc[ai][bj][m][n], 0, 0, 0); __builtin_amdgcn_s_setprio(0); } while (0)
#define PG8_WAIT_V(n) asm volatile("s_waitcnt vmcnt(" #n ")" ::: "memory")
#define PG8_WAIT_L(n) asm volatile("s_waitcnt lgkmcnt(" #n ")" ::: "memory")
#define PG8_BAR __builtin_amdgcn_s_barrier()
#define PG8_SCHED __builtin_amdgcn_sched_barrier(0)
    Unit cur, nxt; int ui = 0;
    if (!S.next(0, cur)) return;
    f32x4 acc[2][2][4][2];
#pragma unroll
    for (int a = 0; a < 2; ++a)
#pragma unroll
        for (int b = 0; b < 2; ++b)
#pragma unroll
            for (int m = 0; m < 4; ++m)
#pragma unroll
                for (int n = 0; n < 2; ++n) acc[a][b][m][n] = (f32x4){0.f, 0.f, 0.f, 0.f};
    bf16x8 At[4][2], B0[2][2], B1[2][2];
    const char* cA = cur.A; const char* cB = cur.B;
    PG8_STAGE(PG8_SB(0, 0), cB, voffB); PG8_STAGE(PG8_SB(0, 1), cB + hstepB, voffB); PG8_STAGE(PG8_SA(0, 0), cA, voffA); PG8_STAGE(PG8_SA(0, 1), cA + hstepA, voffA);
    if (wr == 1) PG8_BAR;
    PG8_WAIT_V(2); PG8_BAR;
    PG8_STAGE(PG8_SB(1, 0), cB + kstep, voffB); PG8_STAGE(PG8_SA(1, 0), cA + kstep, voffA); PG8_STAGE(PG8_SB(1, 1), cB + hstepB + kstep, voffB);
    PG8_WAIT_V(6); PG8_BAR;
    for (;;) {
        const bool has_next = S.next(ui + 1, nxt);
        const char* nA = has_next ? nxt.A : cA; const char* nB = has_next ? nxt.B : cB;
        for (int t = 0; t < nt; t += 2) {
            const bool last = (t == nt - 2);
            const char* a1 = cA + (size_t)(t + 1) * kstep;
            const char* a2 = last ? nA : cA + (size_t)(t + 2) * kstep; const char* b2 = last ? nB : cB + (size_t)(t + 2) * kstep;
            const char* a3 = a2 + kstep; const char* b3 = b2 + kstep;
            PG8_LDB(B0, 0, 0); PG8_LDB(B1, 0, 1); PG8_SCHED; PG8_LDA(At, 0, 0); PG8_STAGE(PG8_SA(1, 1), a1 + hstepA, voffA);
            PG8_WAIT_V(8); PG8_WAIT_L(0); PG8_BAR; PG8_MMA(0, 0, At, B0); PG8_MMA(0, 1, At, B1); PG8_BAR; PG8_SCHED;
            PG8_LDA(At, 0, 1); PG8_STAGE(PG8_SB(0, 0), b2, voffB); PG8_STAGE(PG8_SB(0, 1), b2 + hstepB, voffB); PG8_STAGE(PG8_SA(0, 0), a2, voffA);
            PG8_WAIT_V(8); PG8_WAIT_L(0); PG8_BAR; PG8_MMA(1, 0, At, B0); PG8_MMA(1, 1, At, B1); PG8_BAR; PG8_SCHED;
            PG8_LDB(B0, 1, 0); PG8_LDB(B1, 1, 1); PG8_SCHED; PG8_LDA(At, 1, 0); PG8_STAGE(PG8_SA(0, 1), a2 + hstepA, voffA);
            PG8_WAIT_V(8); PG8_WAIT_L(0); PG8_BAR; PG8_MMA(0, 0, At, B0); PG8_MMA(0, 1, At, B1); PG8_BAR; PG8_SCHED;
            PG8_LDA(At, 1, 1); PG8_STAGE(PG8_SB(1, 0), b3, voffB); PG8_STAGE(PG8_SB(1, 1), b3 + hstepB, voffB); PG8_STAGE(PG8_SA(1, 0), a3, voffA);
            PG8_WAIT_V(8); PG8_WAIT_L(0); PG8_BAR; PG8_MMA(1, 0, At, B0); PG8_MMA(1, 1, At, B1); PG8_BAR; PG8_SCHED;
        }
        if constexpr (ALIGN_EPI) { if (wr == 0) PG8_BAR; }
        E(acc, cur, wr, wc, fr, fq);
        if (!has_next) break;
#pragma unroll
        for (int a = 0; a < 2; ++a)
#pragma unroll
            for (int b = 0; b < 2; ++b)
#pragma unroll
                for (int m = 0; m < 4; ++m)
#pragma unroll
                    for (int n = 0; n < 2; ++n) acc[a][b][m][n] = (f32x4){0.f, 0.f, 0.f, 0.f};
        cur = nxt; cA = nA; cB = nB; ++ui;
        if constexpr (ALIGN_EPI) { if (wr == 1) PG8_BAR; }
    }
    PG8_WAIT_V(0);
    if constexpr (!ALIGN_EPI) { if (wr == 0) PG8_BAR; }
    PG8_BAR;
#undef PG8_SA
#undef PG8_SB
#undef PG8_STAGE
#undef PG8_LDA
#undef PG8_LDB
#undef PG8_MMA
#undef PG8_WAIT_V
#undef PG8_WAIT_L
#undef PG8_BAR
#undef PG8_SCHED
}
}

namespace att {
typedef short bf16x8 __attribute__((ext_vector_type(8)));
typedef short s16x4 __attribute__((ext_vector_type(4)));
typedef float f32x16 __attribute__((ext_vector_type(16)));
typedef unsigned u32x4 __attribute__((ext_vector_type(4)));
typedef __attribute__((address_space(3))) unsigned char* lptr;
constexpr int KN_B = 64 * 256, KR_B = 64 * 128, V_B = 64 * 256, BUF_B = KN_B + KR_B + V_B;
constexpr int OFF_KN = 0, OFF_KR = KN_B, OFF_V = KN_B + KR_B, OFF_WS = 2 * BUF_B, OFF_QR = OFF_WS + 8 * 64 * 4, LDS_BYTES = OFF_QR + 8 * 4096;
#define ATT_SBAR() __builtin_amdgcn_sched_barrier(0)
__device__ __forceinline__ int v_st(int k, int c) { const int kk = (k & ~0xC) | ((k & 4) << 1) | ((k & 8) >> 1); return ((kk >> 3) * 4 + (c >> 5)) * 512 + ((kk & 7) * 32 + (c & 31)) * 2; }
__device__ __forceinline__ int v_rd_base(int lane) { return ((lane & 3) << 3) | (((lane >> 2) & 3) << 6) | (((lane >> 4) & 1) << 5) | (((lane >> 5) & 1) << 8); }
constexpr int v_rd_off(int d0, int ks, int half) { return d0 * 512 + ks * 4096 + half * 2048; }
__device__ __forceinline__ int crow(int r, int hi) { return (r & 3) + 8 * (r >> 2) + 4 * hi; }
__device__ __forceinline__ unsigned cvtpk(float lo, float hi) { unsigned r; asm volatile("v_cvt_pk_bf16_f32 %0, %1, %2" : "=v"(r) : "v"(lo), "v"(hi)); return r; }

__device__ __forceinline__ void partialSM(f32x16& p0, f32x16& p1, float& m_reg, float& alpha) {
    float pmax = p0[0];
#pragma unroll
    for (int r = 1; r < 16; ++r) pmax = fmaxf(pmax, p0[r]);
#pragma unroll
    for (int r = 0; r < 16; ++r) pmax = fmaxf(pmax, p1[r]);
    { auto rr = __builtin_amdgcn_permlane32_swap(__float_as_uint(pmax), __float_as_uint(pmax), false, false); pmax = fmaxf(__uint_as_float(rr[0]), __uint_as_float(rr[1])); }
    float mn;
    if (__builtin_expect(__all(pmax <= m_reg), 0)) { mn = m_reg; alpha = 1.f; }
    else { mn = fmaxf(m_reg, pmax); alpha = __builtin_amdgcn_exp2f(m_reg - mn); m_reg = mn; }
#pragma unroll
    for (int r = 0; r < 16; ++r) { p0[r] = __builtin_amdgcn_exp2f(p0[r] - mn); p1[r] = __builtin_amdgcn_exp2f(p1[r] - mn); }
}
__device__ __forceinline__ void finishSM(f32x16& p0, f32x16& p1, float alpha, float& l_reg, bf16x8& pa0, bf16x8& pa1, bf16x8& pa2, bf16x8& pa3) {
    float ps = 0.f;
#pragma unroll
    for (int r = 0; r < 16; ++r) ps += p0[r];
#pragma unroll
    for (int r = 0; r < 16; ++r) ps += p1[r];
    { auto rr = __builtin_amdgcn_permlane32_swap(__float_as_uint(ps), __float_as_uint(ps), false, false); ps = __uint_as_float(rr[0]) + __uint_as_float(rr[1]); }
    l_reg = l_reg * alpha + ps;
#define ATT_PK4(P, B_, OUT) do { unsigned a0 = cvtpk(P[B_ + 0], P[B_ + 1]), a1 = cvtpk(P[B_ + 2], P[B_ + 3]); unsigned b0 = cvtpk(P[B_ + 4], P[B_ + 5]), b1 = cvtpk(P[B_ + 6], P[B_ + 7]); \
        auto r0 = __builtin_amdgcn_permlane32_swap(a0, b0, false, false); auto r1 = __builtin_amdgcn_permlane32_swap(a1, b1, false, false); \
        u32x4 w = {r0[0], r1[0], r0[1], r1[1]}; OUT = __builtin_bit_cast(bf16x8, w); } while (0)
    ATT_PK4(p0, 0, pa0); ATT_PK4(p0, 8, pa1); ATT_PK4(p1, 0, pa2); ATT_PK4(p1, 8, pa3);
#undef ATT_PK4
}
template <int KB>
__device__ __forceinline__ void qkt(f32x16& p0, f32x16& p1, lptr lds, int r32, int hi, const bf16x8* qr, lptr qsp) {
    p0 = f32x16{}; p1 = f32x16{};
    const lptr kn = lds + KB * BUF_B + OFF_KN + r32 * 256, kr = lds + KB * BUF_B + OFF_KR + r32 * 128;
    const int sw = (r32 & 7) << 4, sw2 = (r32 >> 1) & 7;
#pragma unroll
    for (int d0 = 0; d0 < 8; ++d0) { const int cb = ((2 * d0 + hi) * 16) ^ sw;
        const bf16x8 b0 = *(const __attribute__((address_space(3))) bf16x8*)(kn + cb);
        const bf16x8 b1 = *(const __attribute__((address_space(3))) bf16x8*)(kn + cb + 32 * 256);
        p0 = __builtin_amdgcn_mfma_f32_32x32x16_bf16(b0, qr[d0], p0, 0, 0, 0);
        p1 = __builtin_amdgcn_mfma_f32_32x32x16_bf16(b1, qr[d0], p1, 0, 0, 0);
        if ((d0 & 3) == 3) ATT_SBAR(); }
#pragma unroll
    for (int d0 = 0; d0 < 4; ++d0) { const int cb = ((2 * d0 + hi) ^ sw2) << 4;
        const bf16x8 b0 = *(const __attribute__((address_space(3))) bf16x8*)(kr + cb);
        const bf16x8 b1 = *(const __attribute__((address_space(3))) bf16x8*)(kr + cb + 32 * 128);
        const bf16x8 qv = *(const __attribute__((address_space(3))) bf16x8*)(qsp + d0 * 1024);
        p0 = __builtin_amdgcn_mfma_f32_32x32x16_bf16(b0, qv, p0, 0, 0, 0);
        p1 = __builtin_amdgcn_mfma_f32_32x32x16_bf16(b1, qv, p1, 0, 0, 0); }
}
template <int VB>
__device__ __forceinline__ void pv_tile(f32x16* o, int vb0, bf16x8 pa0, bf16x8 pa1, bf16x8 pa2, bf16x8 pa3) {
#define ATT_TRRD(dst, off) asm volatile("ds_read_b64_tr_b16 %0, %1 offset:%2" : "=&v"(dst) : "v"(vb0), "i"(off) : "memory")
#define ATT_PV_D0(d0) do { s16x4 l0, l1, l2, l3, h0, h1, h2, h3; constexpr int b_ = VB * BUF_B + v_rd_off(d0, 0, 0); \
        ATT_TRRD(l0, b_); ATT_TRRD(h0, b_ + 2048); ATT_TRRD(l1, b_ + 4096); ATT_TRRD(h1, b_ + 6144); ATT_TRRD(l2, b_ + 8192); ATT_TRRD(h2, b_ + 10240); ATT_TRRD(l3, b_ + 12288); ATT_TRRD(h3, b_ + 14336); \
        asm volatile("s_waitcnt lgkmcnt(0)" ::: "memory"); ATT_SBAR(); \
        o[d0] = __builtin_amdgcn_mfma_f32_32x32x16_bf16(pa0, (bf16x8){l0[0], l0[1], l0[2], l0[3], h0[0], h0[1], h0[2], h0[3]}, o[d0], 0, 0, 0); \
        o[d0] = __builtin_amdgcn_mfma_f32_32x32x16_bf16(pa1, (bf16x8){l1[0], l1[1], l1[2], l1[3], h1[0], h1[1], h1[2], h1[3]}, o[d0], 0, 0, 0); \
        o[d0] = __builtin_amdgcn_mfma_f32_32x32x16_bf16(pa2, (bf16x8){l2[0], l2[1], l2[2], l2[3], h2[0], h2[1], h2[2], h2[3]}, o[d0], 0, 0, 0); \
        o[d0] = __builtin_amdgcn_mfma_f32_32x32x16_bf16(pa3, (bf16x8){l3[0], l3[1], l3[2], l3[3], h3[0], h3[1], h3[2], h3[3]}, o[d0], 0, 0, 0); } while (0)
    ATT_PV_D0(0); ATT_PV_D0(1); ATT_PV_D0(2); ATT_PV_D0(3);
#undef ATT_PV_D0
#undef ATT_TRRD
}
__device__ __forceinline__ void attn_unit(int b, int h, int qb, const bf16_t* __restrict__ Q, const bf16_t* __restrict__ KV, const bf16_t* __restrict__ KR, bf16_t* __restrict__ O, lptr lds) {
    const int tid = threadIdx.x, wid = __builtin_amdgcn_readfirstlane(tid >> 6), lane = tid & 63, r32 = lane & 31, hi = lane >> 5;
    const size_t rowb = (size_t)b * SEQ;
    const int q0 = qb * 256 + wid * 32;
    const int NT = 4 * (qb + 1), wlast = 4 * qb + (wid >> 1);
    const int sr = tid >> 4, sc = (tid & 15) * 8;
    const int rr = tid >> 3, rc = tid & 7;
    const int kws = sr * 256 + ((sc * 2) ^ ((sr & 7) << 4)), krs = rr * 128 + ((rc ^ ((rr >> 1) & 7)) << 4), vst0 = v_st(sr, sc), vst1 = v_st(32 + sr, sc);
    const bf16_t* kvsrc = KV + (rowb + sr) * 4096 + h * 256 + sc;
    const bf16_t* krsrc = KR + (rowb + rr) * 64 + rc * 8;
    const int vb0 = (int)(unsigned)(uintptr_t)lds + OFF_V + v_rd_base(lane);
    __attribute__((address_space(3))) float* wsf = (__attribute__((address_space(3))) float*)(lds + OFF_WS) + wid * 64;
    bf16x8 qr[8];
    const lptr qsp = lds + OFF_QR + wid * 4096 + lane * 16;
    { const bf16_t* qrow = Q + (rowb + q0 + r32) * 3072;
#pragma unroll
      for (int d0 = 0; d0 < 8; ++d0) qr[d0] = *(const bf16x8*)(qrow + h * 128 + d0 * 16 + hi * 8);
#pragma unroll
      for (int d0 = 0; d0 < 4; ++d0) *(__attribute__((address_space(3))) bf16x8*)(qsp + d0 * 1024) = *(const bf16x8*)(qrow + 2048 + h * 64 + d0 * 16 + hi * 8); }
    float m_reg = -1e30f, l_reg = 0.f; f32x16 o[4] = {};
    bf16x8 st_k0, st_k1, st_v0, st_v1, st_r;
#define ATT_SLOAD(t) do { const size_t ko = (size_t)(t) * 64 * 4096; st_k0 = *(const bf16x8*)(kvsrc + ko); st_k1 = *(const bf16x8*)(kvsrc + ko + 32 * 4096); \
        st_v0 = *(const bf16x8*)(kvsrc + ko + 128); st_v1 = *(const bf16x8*)(kvsrc + ko + 32 * 4096 + 128); st_r = *(const bf16x8*)(krsrc + (size_t)(t) * 64 * 64); } while (0)
#define ATT_SWRITE(bf) do { const lptr bb = lds + (bf) * BUF_B; *(__attribute__((address_space(3))) bf16x8*)(bb + OFF_KN + kws) = st_k0; *(__attribute__((address_space(3))) bf16x8*)(bb + OFF_KN + kws + 32 * 256) = st_k1; \
        *(__attribute__((address_space(3))) bf16x8*)(bb + OFF_V + vst0) = st_v0; *(__attribute__((address_space(3))) bf16x8*)(bb + OFF_V + vst1) = st_v1; *(__attribute__((address_space(3))) bf16x8*)(bb + OFF_KR + krs) = st_r; } while (0)
#define ATT_TILE(KB) do { f32x16 p0, p1; float alpha; bf16x8 pa0, pa1, pa2, pa3; \
        qkt<KB>(p0, p1, lds, r32, hi, qr, qsp); partialSM(p0, p1, m_reg, alpha); \
        if (__any(alpha < 1.f)) { if (hi == 0) wsf[32 + r32] = alpha; asm volatile("s_waitcnt lgkmcnt(0)" ::: "memory"); \
            _Pragma("unroll") for (int d_ = 0; d_ < 4; ++d_) _Pragma("unroll") for (int r = 0; r < 16; ++r) o[d_][r] *= wsf[32 + crow(r, hi)]; } \
        finishSM(p0, p1, alpha, l_reg, pa0, pa1, pa2, pa3); ATT_SBAR(); pv_tile<KB>(o, vb0, pa0, pa1, pa2, pa3); } while (0)
    ATT_SLOAD(0); ATT_SWRITE(0); __syncthreads();
    for (int t = 0; t < NT; t += 2) {
        ATT_SLOAD(t + 1);
        if (t <= wlast) ATT_TILE(0);
        ATT_SWRITE(1); __syncthreads();
        if (t + 2 < NT) ATT_SLOAD(t + 2);
        if (t + 1 <= wlast) ATT_TILE(1);
        if (t + 2 < NT) ATT_SWRITE(0);
        __syncthreads();
    }
    if (hi == 0) wsf[r32] = l_reg; asm volatile("s_waitcnt lgkmcnt(0)" ::: "memory");
    int ecol = r32, ehi = hi; asm volatile("" : "+v"(ecol), "+v"(ehi));
    bf16_t* Ow = O + (rowb + q0 + 4 * ehi) * D + h * 128 + ecol;
#pragma unroll
    for (int r = 0; r < 16; ++r) { const int orow = (r & 3) + 8 * (r >> 2); const float rl = __builtin_amdgcn_rcpf(wsf[orow + 4 * ehi]);
#pragma unroll
        for (int d0 = 0; d0 < 4; ++d0) { const float v = o[d0][r] * rl; const float vn = __shfl_xor(v, 1);
            if ((r32 & 1) == 0) *(unsigned*)(Ow + (size_t)orow * D + d0 * 32) = cvtpk(v, vn); } }
    __syncthreads();
#undef ATT_SLOAD
#undef ATT_SWRITE
#undef ATT_TILE
}
#undef ATT_SBAR
}

#define GAS __attribute__((address_space(1)))
#define LAS __attribute__((address_space(3)))
typedef unsigned v4u __attribute__((ext_vector_type(4)));
typedef float f32x4 __attribute__((ext_vector_type(4)));
typedef GAS unsigned gu32;
constexpr int NWAVES = 8, NPHASE = 11;
constexpr int RING_OFF = 0, RING_BYTES = 131072, LDSCTL_OFF = RING_BYTES, MISC_OFF = LDSCTL_OFF + 320, LDS_BYTES = 147456;
constexpr int CW_BAR = 4096;
constexpr size_t WO_WIN = 0, WO_WKVQ = 45 * MiB, WO_WOA = 52 * MiB, WO_WOB = 60 * MiB, WO_WO = 68 * MiB;
constexpr size_t WO_WFIN = 0, WO_WFOUT = 44 * MiB;
constexpr int NWIN = 11520;
#define LDS_WAIT() asm volatile("s_waitcnt lgkmcnt(0)" ::: "memory")
__device__ __forceinline__ unsigned pk2(float lo, float hi) { return f2bf(lo) | (f2bf(hi) << 16); }

#define XB_TMO      128
#define XB_XCNT(j)  (256  + 64 * (j))
#define XB_XSUB(j)  (1280 + 64 * (j))
#define XB_XGEN(j)  (2304 + 64 * (j))
#define XB_TOP      3328
#define XB_TOPGEN   3392
#define XCD_BAR_WORDS 3456
#define XB_SPIN_CAP (1u << 18)
__device__ __forceinline__ unsigned xb_ld(unsigned* p)              { return __hip_atomic_load(p, __ATOMIC_RELAXED, __HIP_MEMORY_SCOPE_AGENT); }
__device__ __forceinline__ unsigned xb_add(unsigned* p, unsigned v) { return __hip_atomic_fetch_add(p, v, __ATOMIC_RELAXED, __HIP_MEMORY_SCOPE_AGENT); }
__device__ __forceinline__ unsigned xb_xcc_id() { return (unsigned)__builtin_amdgcn_s_getreg((3 << 11) | 20) & 0xFu; }
#define XB_SPIN(cond, bar) do { unsigned _sp = 0; while (cond) { __builtin_amdgcn_s_sleep(1); \
    if ((++_sp & 255u) == 0u) { if (xb_ld(&(bar)[XB_TMO])) break; if (_sp > XB_SPIN_CAP) { atomicAdd(&(bar)[XB_TMO], 1u); break; } } } } while (0)
struct XcdBarrier { unsigned* bar; unsigned x; volatile LAS unsigned* st; };
__device__ __forceinline__ XcdBarrier xcd_barrier_post(unsigned* bar, volatile LAS unsigned* st) {
    XcdBarrier b; b.bar = bar; b.x = xb_xcc_id(); b.st = st;
    if (threadIdx.x == 0) (void)xb_add(&bar[XB_XCNT(b.x)], 1u);
    return b;
}
__device__ __forceinline__ void xcd_barrier_complete(unsigned* bar, unsigned x, unsigned& nloc, unsigned& nx) {
    const unsigned G = gridDim.x * gridDim.y * gridDim.z;
    unsigned sum, cnt, mine, sp = 0u;
    for (;;) {
        sum = 0u; cnt = 0u; mine = 0u;
#pragma unroll
        for (unsigned j = 0; j < 16; ++j) { const unsigned c = xb_ld(&bar[XB_XCNT(j)]); sum += c; cnt += (c > 0u) ? 1u : 0u; mine = (j == x) ? c : mine; }
        if (sum == G) break;
        __builtin_amdgcn_s_sleep(1);
        if ((++sp & 255u) == 0u) { if (xb_ld(&bar[XB_TMO])) break; if (sp > XB_SPIN_CAP) { atomicAdd(&bar[XB_TMO], 1u); break; } }
    }
    nloc = mine > 0u ? mine : 1u; nx = cnt > 0u ? cnt : 1u;
}
__device__ __forceinline__ void xcd_barrier(const XcdBarrier& b) {
    asm volatile("s_waitcnt vmcnt(0)" ::: "memory");
    __syncthreads();
    if (threadIdx.x == 0) {
        unsigned* bar = b.bar;
        __builtin_amdgcn_s_waitcnt(0);
        unsigned nloc = b.st[0], nx = b.st[1];
        if (nloc == 0u) { xcd_barrier_complete(bar, b.x, nloc, nx); b.st[0] = nloc; b.st[1] = nx; }
        const unsigned old = xb_add(&bar[XB_XSUB(b.x)], 1u);
        const unsigned gen = old / nloc;
        if (old + 1u == (gen + 1u) * nloc) {
            __builtin_amdgcn_fence(__ATOMIC_RELEASE, "agent");
            asm volatile("s_waitcnt vmcnt(0)" ::: "memory");
            const unsigned og = xb_add(&bar[XB_TOP], 1u);
            const unsigned tg = og / nx;
            if (og + 1u == (tg + 1u) * nx) xb_add(&bar[XB_TOPGEN], 1u);
            else XB_SPIN(xb_ld(&bar[XB_TOPGEN]) == tg, bar);
            __builtin_amdgcn_fence(__ATOMIC_ACQUIRE, "agent");
            xb_add(&bar[XB_XGEN(b.x)], 1u);
            asm volatile("s_waitcnt vmcnt(0)" ::: "memory");
        } else {
            XB_SPIN(xb_ld(&bar[XB_XGEN(b.x)]) == gen, bar);
            __builtin_amdgcn_fence(__ATOMIC_ACQUIRE, "agent");
            asm volatile("s_waitcnt vmcnt(0)" ::: "memory");
        }
    }
    __syncthreads();
}

__device__ __forceinline__ float wave_sum(float v) {
#pragma unroll
    for (int o = 1; o < 64; o <<= 1) v += __shfl_xor(v, o);
    return v;
}
__device__ __forceinline__ void transpose_item(const float* __restrict__ W, int K, int N, bf16_t* __restrict__ WT, int dst_row, const float* __restrict__ ks, LAS float* scr, int k0, int n0, int lane) {
#pragma unroll 8
    for (int i = 0; i < 32; ++i) { const int kk = 2 * i + (lane >> 5); float w = W[(size_t)(k0 + kk) * N + n0 + (lane & 31)]; if (ks) w *= ks[k0 + kk]; scr[kk * 33 + (lane & 31)] = w; }
    LDS_WAIT(); asm volatile("" ::: "memory");
    const int c = lane & 7;
#pragma unroll
    for (int j = 0; j < 4; ++j) { const int n = (lane >> 3) + 8 * j; const LAS float* s = scr + (8 * c) * 33 + n;
        v4u o; o.x = pk2(s[0 * 33], s[1 * 33]); o.y = pk2(s[2 * 33], s[3 * 33]); o.z = pk2(s[4 * 33], s[5 * 33]); o.w = pk2(s[6 * 33], s[7 * 33]);
        *(GAS v4u*)(WT + (size_t)(dst_row + n) * K + k0 + 8 * c) = o; }
    LDS_WAIT(); asm volatile("" ::: "memory");
}
__device__ __forceinline__ int map_win(int nb) { const int s = nb * 32; if (s < 1024) return s; if (s < 1088) return 11264 + 128 * (nb - 32); return s - 64; }
__device__ __forceinline__ int map_qb(int nb) { const int s = nb * 32, h = s / 192, r = s % 192; if (r < 128) return 4096 + h * 128 + r; return 4096 + 2048 + (h >> 2) * 256 + ((r - 128) >> 5) * 128 + (h & 3) * 32; }
__device__ __forceinline__ int map_fin(int nb) { int s = nb * 32; if (s < DFF) return (s >> 7) * 256 + (s & 127); s -= DFF; return (s >> 7) * 256 + 128 + (s & 127); }

struct Args { const void* in[20]; float* out; unsigned char* ws; int ph_lo, ph_hi; };

__global__ void __launch_bounds__(NWAVES * 64, 2) mega_fwd(Args args) {
    extern __shared__ __attribute__((aligned(16))) unsigned char lds_raw[];
    LAS unsigned char* lds = (LAS unsigned char*)lds_raw;
    volatile LAS unsigned* MISC = (volatile LAS unsigned*)(lds + MISC_OFF);
    const int tid = threadIdx.x, lane = tid & 63, wave = __builtin_amdgcn_readfirstlane(tid >> 6);
    const int G = gridDim.x, bx = blockIdx.x, vcu = (G % 8 == 0) ? (bx % 8) * (G / 8) + bx / 8 : bx;
    const int gw = vcu * NWAVES + wave, NGW = G * NWAVES;
    unsigned char* ws = args.ws;
    const float* x = (const float*)args.in[0]; const float* cvec = (const float*)args.in[1]; const int* pos = (const int*)args.in[2];
    const float* w_ada = (const float*)args.in[3]; const float* b_ada = (const float*)args.in[4]; const float* w_in = (const float*)args.in[5];
    const float* g_q = (const float*)args.in[6]; const float* w_qb = (const float*)args.in[7]; const float* g_kv = (const float*)args.in[8]; const float* w_kvb = (const float*)args.in[9];
    const float* w_oa = (const float*)args.in[10]; const float* w_conv = (const float*)args.in[11]; const float* w_ob = (const float*)args.in[12]; const float* w_o = (const float*)args.in[13];
    const float* ln1g = (const float*)args.in[14]; const float* ln1b = (const float*)args.in[15]; const float* w_fi = (const float*)args.in[16]; const float* w_fo = (const float*)args.in[17];
    const float* ln2g = (const float*)args.in[18]; const float* ln2b = (const float*)args.in[19];
    float* out = args.out;
    float* MOD = (float*)(ws + WS_MOD); float* MODP = (float*)(ws + WS_MODP); float* COS = (float*)(ws + WS_COS); float* SIN = (float*)(ws + WS_SIN); float* SSQ = (float*)(ws + WS_SSQ);
    bf16_t* KR = (bf16_t*)(ws + WS_KROPE); bf16_t* A0b = (bf16_t*)(ws + WS_A0);
    bf16_t* QA = (bf16_t*)(ws + WS_QA); bf16_t* KVA = (bf16_t*)(ws + WS_KVA); bf16_t* CB = (bf16_t*)(ws + WS_CB); bf16_t* CC = (bf16_t*)(ws + WS_CC); bf16_t* CX = (bf16_t*)(ws + WS_CX);
    bf16_t* SGA = (bf16_t*)(ws + WS_SGA); bf16_t* Qb = (bf16_t*)(ws + WS_Q); bf16_t* KVb = (bf16_t*)(ws + WS_KV);
    bf16_t* ATT = CB; bf16_t* ACT = CB; bf16_t* MG = Qb; bf16_t* YB = A0b;
    bf16_t* W_IN = (bf16_t*)(ws + WS_W + WO_WIN); bf16_t* W_KVQ = (bf16_t*)(ws + WS_W + WO_WKVQ); bf16_t* W_OA = (bf16_t*)(ws + WS_W + WO_WOA); bf16_t* W_OB = (bf16_t*)(ws + WS_W + WO_WOB);
    bf16_t* W_O = (bf16_t*)(ws + WS_W + WO_WO); bf16_t* W_FIN = (bf16_t*)(ws + WS_W + WO_WFIN); bf16_t* W_FOUT = (bf16_t*)(ws + WS_W + WO_WFOUT);

    for (int u = tid; u < (LDS_BYTES - LDSCTL_OFF) / 4; u += NWAVES * 64) ((LAS unsigned*)(lds + LDSCTL_OFF))[u] = 0u;
    __syncthreads();
    const int lo = args.ph_lo, hi = args.ph_hi;
    const bool multi = (hi - lo) > 1 && hi <= NPHASE;
    XcdBarrier bar; bar.bar = (unsigned*)(ws + WS_CTL) + CW_BAR; bar.x = 0; bar.st = nullptr;
    if (multi) bar = xcd_barrier_post((unsigned*)(ws + WS_CTL) + CW_BAR, MISC + 8);
#define IN(k) (lo <= (k) && (k) < hi)
#define SEAM(k) do { if (multi && IN(k) && IN((k) + 1)) xcd_barrier(bar); } while (0)
    LAS float* scr = (LAS float*)(lds + RING_OFF + wave * 16384);

    if (IN(0) || IN(11)) {
        if (IN(0)) {
            for (int it = gw; it < 16 * 48; it += NGW) { const int slab = it / 48, c0 = (it % 48) * 256 + lane * 4, k0 = slab * 128;
                f32x4 a0 = {0.f, 0.f, 0.f, 0.f}, a1 = a0, a2 = a0, a3 = a0;
#pragma unroll 8
                for (int k = 0; k < 128; ++k) { const f32x4 w = *(const f32x4*)(w_ada + (size_t)(k0 + k) * NMOD + c0);
                    const float v0 = cvec[k0 + k], v1 = cvec[D + k0 + k], v2 = cvec[2 * D + k0 + k], v3 = cvec[3 * D + k0 + k];
                    a0 += w * (v0 / (1.f + __expf(-v0))); a1 += w * (v1 / (1.f + __expf(-v1))); a2 += w * (v2 / (1.f + __expf(-v2))); a3 += w * (v3 / (1.f + __expf(-v3))); }
                float* dst = MODP + (size_t)(slab * 4) * NMOD + c0;
                *(f32x4*)(dst) = a0; *(f32x4*)(dst + NMOD) = a1; *(f32x4*)(dst + 2 * NMOD) = a2; *(f32x4*)(dst + 3 * NMOD) = a3; }
            for (int idx = gw * 64 + lane; idx < M * 32; idx += NGW * 64) { const int m = idx >> 5, i = idx & 31;
                const float inv = 1.0f / powf(10000.f, (float)(2 * i) / 64.f); const float ang = (float)pos[m] * inv; COS[idx] = cosf(ang); SIN[idx] = sinf(ang); }
        }
        constexpr int I_IN = 32 * 354, I_KV = 8 * 128, I_QB = 8 * 96, I_SQ = 32 * 64, NIT = I_IN + I_KV + I_QB + 3 * I_SQ;
        for (int it = gw; it < NIT; it += NGW) { int r = it;
            if (r < I_IN) { const int kb = r / 354, nb = r % 354; transpose_item(w_in, D, DIN, W_IN, map_win(nb), nullptr, scr, kb * 64, nb * 32, lane); continue; } r -= I_IN;
            if (r < I_KV) { const int kb = r / 128, nb = r % 128; transpose_item(w_kvb, 512, 4096, W_KVQ, nb * 32, g_kv, scr, kb * 64, nb * 32, lane); continue; } r -= I_KV;
            if (r < I_QB) { const int kb = r / 96, nb = r % 96; transpose_item(w_qb, 512, 3072, W_KVQ, map_qb(nb), g_q, scr, kb * 64, nb * 32, lane); continue; } r -= I_QB;
            { const int which = r / I_SQ; r %= I_SQ; const int kb = r / 64, nb = r % 64;
              transpose_item(which == 0 ? w_oa : which == 1 ? w_ob : w_o, D, D, which == 0 ? W_OA : which == 1 ? W_OB : W_O, nb * 32, nullptr, scr, kb * 64, nb * 32, lane); } }
        for (int idx = gw * 64 + lane; idx < 192 * 256; idx += NGW * 64) { const int r = idx >> 8, c = idx & 255; const int row = 11264 + (r < 96 ? 32 + r : 160 + (r - 96));
            *(GAS v4u*)(W_IN + (size_t)row * D + c * 8) = (v4u){0u, 0u, 0u, 0u}; }
        SEAM(0);
    }
    if (IN(1)) {
        const int r0 = vcu * (M / G), b = r0 / SEQ;
        LAS float* sm = (LAS float*)(lds + RING_OFF);
        for (int j = tid; j < 2 * D; j += NWAVES * 64) { float s = b_ada[j];
#pragma unroll
            for (int sl = 0; sl < 16; ++sl) s += MODP[(size_t)(sl * 4 + b) * NMOD + j];
            sm[j] = s; }
        for (int idx = vcu * (BATCH * NMOD / G) + tid; idx < (vcu + 1) * (BATCH * NMOD / G); idx += NWAVES * 64) { const int bb = idx / NMOD, n = idx % NMOD; float s = b_ada[n];
#pragma unroll
            for (int sl = 0; sl < 16; ++sl) s += MODP[(size_t)(sl * 4 + bb) * NMOD + n];
            MOD[idx] = s; }
        __syncthreads();
        for (int r = wave; r < M / G; r += NWAVES) { const int m = r0 + r; const f32x4* xr = (const f32x4*)(x + (size_t)m * D) + lane; unsigned long long* o8 = (unsigned long long*)(A0b + (size_t)m * D) + lane;
#pragma unroll
            for (int j = 0; j < 8; ++j) { const f32x4 v = xr[64 * j]; const int c = 4 * lane + 256 * j;
                const f32x4 sh = *(const LAS f32x4*)(sm + c), sc = *(const LAS f32x4*)(sm + D + c); const f32x4 y = v * (sc + 1.0f) + sh;
                o8[64 * j] = (unsigned long long)pk2(y[0], y[1]) | ((unsigned long long)pk2(y[2], y[3]) << 32); } }
        __syncthreads();
        SEAM(1);
    }
    if (IN(2)) {
        pg8::Sched S{0, M / 256, NWIN / 256, (M / 256) * (NWIN / 256), G, bx, (const char*)A0b, nullptr, (const char*)W_IN, nullptr, (size_t)256 * D * 2, (size_t)256 * D * 2};
        pg8::EpiProj E{QA, KVA, CB, SGA, KR, SSQ, COS, SIN};
        pg8::gemm_phase<pg8::EpiProj, true>(lds + RING_OFF, D, D, D, S, E);
        SEAM(2);
    }
    if (IN(3)) {
        for (int it = gw; it < (M / 16) * 4; it += NGW) { const int rb = it >> 2, c0 = (it & 3) * 512 + lane * 8, m0 = rb * 16;
            f32x4 w0a = *(const f32x4*)(w_conv + c0), w0b = *(const f32x4*)(w_conv + c0 + 4), w1a = *(const f32x4*)(w_conv + D + c0), w1b = *(const f32x4*)(w_conv + D + c0 + 4), w2a = *(const f32x4*)(w_conv + 2 * D + c0), w2b = *(const f32x4*)(w_conv + 2 * D + c0 + 4);
            f32x4 zm2a = {0.f, 0.f, 0.f, 0.f}, zm2b = zm2a, zm1a = zm2a, zm1b = zm2a;
            if ((m0 % SEQ) != 0) { f32x4 ca, cb_, xa, xb; pg8::unpack8(*(const v4u*)(CC + (size_t)(m0 - 2) * D + c0), ca, cb_); pg8::unpack8(*(const v4u*)(CX + (size_t)(m0 - 2) * D + c0), xa, xb); zm2a = ca * xa; zm2b = cb_ * xb;
                pg8::unpack8(*(const v4u*)(CC + (size_t)(m0 - 1) * D + c0), ca, cb_); pg8::unpack8(*(const v4u*)(CX + (size_t)(m0 - 1) * D + c0), xa, xb); zm1a = ca * xa; zm1b = cb_ * xb; }
#pragma unroll 4
            for (int r = 0; r < 16; ++r) { const size_t o = (size_t)(m0 + r) * D + c0; f32x4 ca, cb_, xa, xb, ba, bb;
                pg8::unpack8(*(const v4u*)(CC + o), ca, cb_); pg8::unpack8(*(const v4u*)(CX + o), xa, xb); pg8::unpack8(*(const v4u*)(CB + o), ba, bb);
                const f32x4 za = ca * xa, zb = cb_ * xb;
                *(v4u*)(YB + o) = pg8::pack8(ba * (w0a * zm2a + w1a * zm1a + w2a * za), bb * (w0b * zm2b + w1b * zm1b + w2b * zb));
                zm2a = zm1a; zm2b = zm1b; zm1a = za; zm1b = zb; } }
        pg8::Sched S{1, M / 256, 28, (M / 256) * 28, G, bx, (const char*)KVA, (const char*)QA, (const char*)W_KVQ, nullptr, (size_t)256 * 512 * 2, (size_t)256 * 512 * 2};
        pg8::EpiQKV E{KVb, Qb, SSQ, COS, SIN};
        pg8::gemm_phase<pg8::EpiQKV, true>(lds + RING_OFF, 512, 512, 512, S, E);
        SEAM(3);
    }
    if (IN(4)) {
        for (int uidx = vcu; uidx < BATCH * NH * 4; uidx += G) { const int bh = uidx >> 2, s = uidx & 3;
            for (int pass = 0; pass < 2; ++pass) att::attn_unit(bh / NH, bh % NH, pass ? 7 - s : s, Qb, KVb, KR, ATT, lds + RING_OFF); }
        SEAM(4);
    }
    if (IN(5)) {
        pg8::Sched S{2, M / 256, D / 256, (M / 256) * (D / 256), G, bx, (const char*)ATT, (const char*)YB, (const char*)W_OA, (const char*)W_OB, (size_t)256 * D * 2, (size_t)256 * D * 2};
        pg8::EpiMerge E{MG, SGA};
        pg8::gemm_phase<pg8::EpiMerge, true>(lds + RING_OFF, D, D, D, S, E);
        SEAM(5);
    }
    if (IN(6)) {
        pg8::Sched S{0, M / 256, D / 256, (M / 256) * (D / 256), G, bx, (const char*)MG, nullptr, (const char*)W_O, nullptr, (size_t)256 * D * 2, (size_t)256 * D * 2};
        pg8::EpiPre E{x, out, MOD + 2 * D};
        pg8::gemm_phase<pg8::EpiPre, false>(lds + RING_OFF, D, D, D, S, E);
        SEAM(6);
    }
    if (IN(7) || IN(12)) {
        if (IN(7)) {
            for (int m = gw; m < M; m += NGW) { const int b = m / SEQ; f32x4* xr = (f32x4*)(out + (size_t)m * D) + lane; f32x4 v[8]; float s = 0.f;
#pragma unroll
                for (int j = 0; j < 8; ++j) { v[j] = xr[64 * j]; s += (v[j][0] + v[j][1]) + (v[j][2] + v[j][3]); }
                const float mean = wave_sum(s) * (1.f / D); float s2 = 0.f;
#pragma unroll
                for (int j = 0; j < 8; ++j) { v[j] = v[j] - mean; s2 += (v[j][0] * v[j][0] + v[j][1] * v[j][1]) + (v[j][2] * v[j][2] + v[j][3] * v[j][3]); }
                const float rstd = 1.f / sqrtf(wave_sum(s2) * (1.f / D) + LN_EPS);
                unsigned long long* o8 = (unsigned long long*)(A0b + (size_t)m * D) + lane;
#pragma unroll
                for (int j = 0; j < 8; ++j) { const int c = 4 * lane + 256 * j; const f32x4 y = v[j] * rstd * *(const f32x4*)(ln1g + c) + *(const f32x4*)(ln1b + c); xr[64 * j] = y;
                    const f32x4 u2 = y * (*(const f32x4*)(MOD + (size_t)b * NMOD + 4 * D + c) + 1.0f) + *(const f32x4*)(MOD + (size_t)b * NMOD + 3 * D + c);
                    o8[64 * j] = (unsigned long long)pk2(u2[0], u2[1]) | ((unsigned long long)pk2(u2[2], u2[3]) << 32); } }
        }
        constexpr int I_FI = 32 * 352, I_FO = 88 * 64;
        for (int it = gw; it < I_FI + I_FO; it += NGW) { int r = it;
            if (r < I_FI) { const int kb = r / 352, nb = r % 352; transpose_item(w_fi, D, 2 * DFF, W_FIN, map_fin(nb), nullptr, scr, kb * 64, nb * 32, lane); continue; } r -= I_FI;
            { const int kb = r / 64, nb = r % 64; transpose_item(w_fo, DFF, D, W_FOUT, nb * 32, nullptr, scr, kb * 64, nb * 32, lane); } }
        SEAM(7);
    }
    if (IN(8)) {
        pg8::Sched S{0, M / 256, 2 * DFF / 256, (M / 256) * (2 * DFF / 256), G, bx, (const char*)A0b, nullptr, (const char*)W_FIN, nullptr, (size_t)256 * D * 2, (size_t)256 * D * 2};
        pg8::EpiAct E{ACT};
        pg8::gemm_phase<pg8::EpiAct, true>(lds + RING_OFF, D, D, D, S, E);
        SEAM(8);
    }
    if (IN(9)) {
        pg8::Sched S{0, M / 256, D / 256, (M / 256) * (D / 256), G, bx, (const char*)ACT, nullptr, (const char*)W_FOUT, nullptr, (size_t)256 * DFF * 2, (size_t)256 * DFF * 2};
        pg8::EpiPre E{out, out, MOD + 5 * D};
        pg8::gemm_phase<pg8::EpiPre, false>(lds + RING_OFF, DFF, DFF, DFF, S, E);
        SEAM(9);
    }
    if (IN(10)) {
        for (int m = gw; m < M; m += NGW) { f32x4* xr = (f32x4*)(out + (size_t)m * D) + lane; f32x4 v[8]; float s = 0.f;
#pragma unroll
            for (int j = 0; j < 8; ++j) { v[j] = xr[64 * j]; s += (v[j][0] + v[j][1]) + (v[j][2] + v[j][3]); }
            const float mean = wave_sum(s) * (1.f / D); float s2 = 0.f;
#pragma unroll
            for (int j = 0; j < 8; ++j) { v[j] = v[j] - mean; s2 += (v[j][0] * v[j][0] + v[j][1] * v[j][1]) + (v[j][2] * v[j][2] + v[j][3] * v[j][3]); }
            const float rstd = 1.f / sqrtf(wave_sum(s2) * (1.f / D) + LN_EPS);
#pragma unroll
            for (int j = 0; j < 8; ++j) { const int c = 4 * lane + 256 * j; xr[64 * j] = v[j] * rstd * *(const f32x4*)(ln2g + c) + *(const f32x4*)(ln2b + c); } }
    }
#undef IN
#undef SEAM
}
#ifndef MK_MODE
#define MK_MODE 0
#endif
#ifndef MK_FASTMASK
#define MK_FASTMASK 0x7ff
#endif
extern "C" void kernel_launch(void* const* d_in, const int* in_sizes, int n_in, void* d_out, int out_size, void* d_ws, size_t ws_size, hipStream_t stream) {
    static int grid = 0;
    if (grid == 0) {
        if (n_in != 20 || in_sizes[0] != M * D || out_size != M * D || ws_size < WS_END) {
            fprintf(stderr, "kernel_launch: unexpected shapes: n_in %d in0 %d out %d ws %zu (need >= %zu)\n", n_in, n_in > 0 ? in_sizes[0] : -1, out_size, ws_size, (size_t)WS_END); grid = -1; return; }
        int dev = 0, cus = 0, per_cu = 0;
        if (hipGetDevice(&dev) != hipSuccess || hipDeviceGetAttribute(&cus, hipDeviceAttributeMultiprocessorCount, dev) != hipSuccess) { fprintf(stderr, "kernel_launch: device query failed\n"); grid = -1; return; }
        if (hipFuncSetAttribute((const void*)mega_fwd, hipFuncAttributeMaxDynamicSharedMemorySize, LDS_BYTES) != hipSuccess) { fprintf(stderr, "kernel_launch: hipFuncSetAttribute failed\n"); grid = -1; return; }
        if (hipOccupancyMaxActiveBlocksPerMultiprocessor(&per_cu, (const void*)mega_fwd, NWAVES * 64, LDS_BYTES) != hipSuccess || per_cu < 1)
            fprintf(stderr, "kernel_launch: note: occupancy query reports %d workgroups per CU\n", per_cu);
        (void)hipGetLastError();
        grid = cus;
        if (grid != 256) fprintf(stderr, "kernel_launch: note: %d CUs (tuned for 256)\n", grid);
    }
    if (grid < 0) return;
    const float* x = (const float*)d_in[0]; const float* c = (const float*)d_in[1]; const int* pos = (const int*)d_in[2];
    const float* w_ada = (const float*)d_in[3]; const float* b_ada = (const float*)d_in[4]; const float* w_in = (const float*)d_in[5];
    const float* g_q = (const float*)d_in[6]; const float* w_qb = (const float*)d_in[7]; const float* g_kv = (const float*)d_in[8]; const float* w_kvb = (const float*)d_in[9];
    const float* w_oa = (const float*)d_in[10]; const float* w_conv = (const float*)d_in[11]; const float* w_ob = (const float*)d_in[12]; const float* w_o = (const float*)d_in[13];
    const float* ln1g = (const float*)d_in[14]; const float* ln1b = (const float*)d_in[15]; const float* w_fi = (const float*)d_in[16]; const float* w_fo = (const float*)d_in[17];
    const float* ln2g = (const float*)d_in[18]; const float* ln2b = (const float*)d_in[19];
    float* out = (float*)d_out; unsigned char* ws = (unsigned char*)d_ws;
    float* mod = (float*)(ws + WS_MOD); float* cs = (float*)(ws + WS_COS); float* sn = (float*)(ws + WS_SIN); float* ssq = (float*)(ws + WS_SSQ);
    bf16_t* KR = (bf16_t*)(ws + WS_KROPE); bf16_t* U = (bf16_t*)(ws + WS_A0); bf16_t* YB = (bf16_t*)(ws + WS_A0); bf16_t* U2 = (bf16_t*)(ws + WS_A0);
    bf16_t* QA = (bf16_t*)(ws + WS_QA); bf16_t* KVA = (bf16_t*)(ws + WS_KVA); bf16_t* CB = (bf16_t*)(ws + WS_CB); bf16_t* CC = (bf16_t*)(ws + WS_CC); bf16_t* CX = (bf16_t*)(ws + WS_CX);
    bf16_t* ATT = (bf16_t*)(ws + WS_CB); bf16_t* ACT = (bf16_t*)(ws + WS_CB); bf16_t* SGA = (bf16_t*)(ws + WS_SGA); bf16_t* SGB = (bf16_t*)(ws + WS_SGB);
    bf16_t* Qb = (bf16_t*)(ws + WS_Q); bf16_t* MG = (bf16_t*)(ws + WS_Q); bf16_t* KVb = (bf16_t*)(ws + WS_KV);

    (void)hipMemsetAsync(ws + WS_CTL, 0, 1 * MiB, stream);
    Args a{};
    for (int i = 0; i < 20; ++i) a.in[i] = d_in[i];
    a.out = out; a.ws = ws;
#define LAUNCH_MEGA(lo_, hi_) do { a.ph_lo = (lo_); a.ph_hi = (hi_); hipLaunchKernelGGL(mega_fwd, dim3(grid), dim3(NWAVES * 64), LDS_BYTES, stream, a); } while (0)
    if (MK_MODE == 0) { LAUNCH_MEGA(0, NPHASE); return; }
    if (MK_MODE == 1) { for (int p = 0; p < NPHASE; ++p) LAUNCH_MEGA(p, p + 1); return; }
    const unsigned fm = MK_FASTMASK;
#define FAST(p) ((fm >> (p)) & 1u)
    if (!FAST(0) && (FAST(2) || FAST(3) || FAST(5) || FAST(6))) LAUNCH_MEGA(11, 12);
    if (FAST(0)) LAUNCH_MEGA(0, 1); else { nv_mod<<<BATCH * NMOD / 256, 256, 0, stream>>>(c, w_ada, b_ada, mod); nv_rope<<<M * 32 / 256, 256, 0, stream>>>(pos, cs, sn); }
    if (FAST(1)) LAUNCH_MEGA(1, 2); else nv_u<<<M * D / 256, 256, 0, stream>>>(x, mod, U);
    if (FAST(2)) LAUNCH_MEGA(2, 3); else {
        nv_gemm<EpProj><<<dim3(11264 / 64, M / 64), 256, 0, stream>>>(U, nullptr, D, w_in, nullptr, DIN, nullptr, D, EpProj{QA, KVA, CB, CC, CX, SGA, SGB});
        nv_gemm<EpKrope><<<dim3(1, M / 64), 256, 0, stream>>>(U, nullptr, D, w_in, w_in, DIN, nullptr, D, EpKrope{KR, cs, sn});
        nv_ssq<<<M / 256, 256, 0, stream>>>(QA, KVA, ssq); }
    if (FAST(3)) LAUNCH_MEGA(3, 4); else {
        nv_gemm<EpQnope><<<dim3(2048 / 64, M / 64), 256, 0, stream>>>(QA, nullptr, 512, w_qb, nullptr, 3072, g_q, 512, EpQnope{Qb, ssq});
        nv_gemm<EpQrope><<<dim3(512 / 64, M / 64), 256, 0, stream>>>(QA, nullptr, 512, w_qb, w_qb, 3072, g_q, 512, EpQrope{Qb, ssq, cs, sn});
        nv_gemm<EpKV><<<dim3(4096 / 64, M / 64), 256, 0, stream>>>(KVA, nullptr, 512, w_kvb, nullptr, 4096, g_kv, 512, EpKV{KVb, ssq});
        nv_conv<<<M * D / 256, 256, 0, stream>>>(CB, CC, CX, w_conv, YB); }
    if (FAST(4)) LAUNCH_MEGA(4, 5); else nv_attn<<<BATCH * NH * SEQ, 256, 0, stream>>>(Qb, KVb, KR, ATT);
    if (FAST(5)) LAUNCH_MEGA(5, 6); else nv_gemm<EpMerge><<<dim3(D / 64, M / 64), 256, 0, stream>>>(ATT, YB, D, w_oa, w_ob, D, nullptr, D, EpMerge{MG, SGA, SGB});
    if (FAST(6)) LAUNCH_MEGA(6, 7); else nv_gemm<EpPre><<<dim3(D / 64, M / 64), 256, 0, stream>>>(MG, nullptr, D, w_o, nullptr, D, nullptr, D, EpPre{x, out, mod + 2 * D});
    if (FAST(7)) LAUNCH_MEGA(7, 8); else { nv_ln<<<M, 256, 0, stream>>>(out, ln1g, ln1b, mod, U2); if (FAST(8) || FAST(9)) LAUNCH_MEGA(12, 13); }
    if (FAST(8)) LAUNCH_MEGA(8, 9); else nv_gemm<EpAct><<<dim3(DFF / 64, M / 64), 256, 0, stream>>>(U2, nullptr, D, w_fi, w_fi, 2 * DFF, nullptr, D, EpAct{ACT});
    if (FAST(9)) LAUNCH_MEGA(9, 10); else nv_gemm<EpPre><<<dim3(D / 64, M / 64), 256, 0, stream>>>(ACT, nullptr, DFF, w_fo, nullptr, D, nullptr, DFF, EpPre{out, out, mod + 5 * D});
    if (FAST(10)) LAUNCH_MEGA(10, 11); else nv_ln<<<M, 256, 0, stream>>>(out, ln2g, ln2b, mod, nullptr);
#undef FAST
#undef LAUNCH_MEGA
}
```

```cpp
#include <hip/hip_runtime.h>
#include <cstdio>
#include <cstdint>
#include <cmath>

namespace cfg {
constexpr int D = 2048, BATCH = 4, SEQ = 2048, M = BATCH * SEQ;
constexpr int NH = 16, DFF = 5632, DIN = 11328, NMOD = 6 * D;
constexpr float ALPHA = 1.189207115002721f;
constexpr float LN_EPS = 1e-5f, RMS_EPS = 1e-6f;
constexpr float QS = 0.07216878364870322f * 1.4426950408889634f;
constexpr size_t MiB = 1u << 20;
constexpr size_t WS_CTL = 0, WS_MOD = 1 * MiB, WS_MODP = 2 * MiB, WS_COS = 5 * MiB, WS_SIN = 6 * MiB, WS_SSQ = 7 * MiB, WS_KROPE = 8 * MiB;
constexpr size_t WS_W = 16 * MiB;
constexpr size_t WS_WFIN = 92 * MiB;
constexpr size_t WS_A0 = 136 * MiB;
constexpr size_t WS_QA = 168 * MiB, WS_KVA = 176 * MiB;
constexpr size_t WS_CB = 184 * MiB, WS_Z = 216 * MiB;
constexpr size_t WS_SGA = 248 * MiB, WS_SGB = 280 * MiB;
constexpr size_t WS_Q = 312 * MiB;
constexpr size_t WS_KV = 360 * MiB;
constexpr size_t WS_END = 424 * MiB;
}
using namespace cfg;

typedef unsigned short bf16_t;
__device__ __forceinline__ unsigned f2bf(float f) { unsigned u = __builtin_bit_cast(unsigned, f); return (u + 0x7fffu + ((u >> 16) & 1u)) >> 16; }
namespace pg8 {
#define PG8_LAS __attribute__((address_space(3)))
typedef short bf16x8 __attribute__((ext_vector_type(8)));
typedef float f32x4 __attribute__((ext_vector_type(4)));
typedef unsigned u32x4 __attribute__((ext_vector_type(4)));
constexpr int BM = 256, BK = 64, HALF = 128, HTB = HALF * BK * 2  , STAGE_BYTES = 8 * HTB, NXCD = 8, WGM = 8;
__host__ __device__ __forceinline__ int lds_byte(int r, int c) { const int st = (r >> 4) * 2 + (c >> 5), rr = r & 15, cc = c & 31, ob = rr * 64 + cc * 2; return st * 1024 + (ob ^ (((ob >> 9) & 1) << 5)); }
__host__ __device__ __forceinline__ void stage_rc(int b, int& R, int& C) { const int st = b / 1024, sb = b % 1024, swz = sb ^ (((sb >> 9) & 1) << 5); R = (st >> 1) * 16 + swz / 64; C = (st & 1) * 32 + (swz % 64) / 2; }
__host__ __device__ __forceinline__ int perm32(int rho) { const int n = rho >> 4, i = rho & 15; return 8 * (i >> 2) + 4 * n + (i & 3); }

struct Unit { int pm, pn, flag; const char* A; const char* B; };
struct Sched {
    int kind, nM, nN, nwg, G, c; const char *A0, *A1, *B0, *B1; size_t a_tile, b_tile;
    __device__ __forceinline__ bool next(int i, Unit& u) const {
        int L, flag = 0;
        if (kind == 2) { L = (i >> 1) * G + c; flag = i & 1; } else L = i * G + c;
        if (L >= nwg) return false;
        int wgid = L; { const int q = nwg / NXCD, r = nwg % NXCD, xcd = wgid % NXCD, off = wgid / NXCD; wgid = (xcd < r ? xcd * (q + 1) : r * (q + 1) + (xcd - r) * q) + off; }
        const int nig = WGM * nN, gid = wgid / nig, fm = gid * WGM, gsz = (nM - fm) < WGM ? (nM - fm) : WGM;
        const int pm = fm + ((wgid % nig) % gsz), pn = (wgid % nig) / gsz;
        u.pm = pm; u.pn = pn; u.flag = flag;
        if (kind == 0) { u.A = A0 + (size_t)pm * a_tile; u.B = B0 + (size_t)pn * b_tile; }
        else if (kind == 1) { u.A = (pn < 16 ? A0 : A1) + (size_t)pm * a_tile; u.B = B0 + (size_t)pn * b_tile; }
        else { u.A = (flag ? A1 : A0) + (size_t)pm * a_tile; u.B = (flag ? B1 : B0) + (size_t)pn * b_tile; }
        return true;
    }
};
__device__ __forceinline__ unsigned cvt_pk_bf16(float lo, float hi) { unsigned r; asm volatile("v_cvt_pk_bf16_f32 %0, %1, %2" : "=v"(r) : "v"(lo), "v"(hi)); return r; }
__device__ __forceinline__ u32x4 pack8(f32x4 a, f32x4 b) { u32x4 w; w.x = cvt_pk_bf16(a[0], a[1]); w.y = cvt_pk_bf16(a[2], a[3]); w.z = cvt_pk_bf16(b[0], b[1]); w.w = cvt_pk_bf16(b[2], b[3]); return w; }
__device__ __forceinline__ void unpack8(u32x4 w, f32x4& a, f32x4& b) {
    a[0] = __builtin_bit_cast(float, w.x << 16); a[1] = __builtin_bit_cast(float, w.x & 0xffff0000u); a[2] = __builtin_bit_cast(float, w.y << 16); a[3] = __builtin_bit_cast(float, w.y & 0xffff0000u);
    b[0] = __builtin_bit_cast(float, w.z << 16); b[1] = __builtin_bit_cast(float, w.z & 0xffff0000u); b[2] = __builtin_bit_cast(float, w.w << 16); b[3] = __builtin_bit_cast(float, w.w & 0xffff0000u); }
__device__ __forceinline__ float fsig(float v) { return __builtin_amdgcn_rcpf(1.f + __builtin_amdgcn_exp2f(-1.4426950408889634f * v)); }
__device__ __forceinline__ f32x4 fsig4(f32x4 v) { f32x4 r; r[0] = fsig(v[0]); r[1] = fsig(v[1]); r[2] = fsig(v[2]); r[3] = fsig(v[3]); return r; }

struct EpiProj {
    static constexpr bool PERM = true;
    bf16_t *QA, *KVA, *CB, *Z, *SG, *KR; float* SSQ; const float *COS, *SIN;
    __device__ __forceinline__ void operator()(const f32x4 (&acc)[2][2][4][2], const Unit& u, int wr, int wc, int fr, int fq) const {
        const int pn = u.pn, row0 = u.pm * BM + wr * 64 + fr, cw = wc * 32 + 8 * fq;
        if (pn >= 12 && pn < 28) {
#pragma unroll
            for (int ai = 0; ai < 2; ++ai)
#pragma unroll
                for (int m = 0; m < 4; ++m)
                    *(u32x4*)(Z + (size_t)(row0 + ai * HALF + m * 16) * D + (pn - 12) * HALF + cw) = pack8(acc[ai][0][m][0] * acc[ai][1][m][0], acc[ai][0][m][1] * acc[ai][1][m][1]);
        } else if (pn < 44) {
            bf16_t* base; int ldc, col0; const bool sig = pn >= 28, stat = pn < 4;
            if (pn < 4) { base = pn < 2 ? QA : KVA; ldc = 512; col0 = (pn & 1) * 256; }
            else if (pn < 12) { base = CB; ldc = D; col0 = (pn - 4) * 256; }
            else { const int t = pn - 28; base = SG + (size_t)(t >> 3) * ((size_t)M * D); ldc = D; col0 = (t & 7) * 256; }
#pragma unroll
            for (int ai = 0; ai < 2; ++ai)
#pragma unroll
                for (int m = 0; m < 4; ++m) { const int row = row0 + ai * HALF + m * 16; bf16_t* rowp = base + (size_t)row * ldc + col0 + cw; float ss = 0.f;
#pragma unroll
                    for (int bj = 0; bj < 2; ++bj) { f32x4 v0 = acc[ai][bj][m][0], v1 = acc[ai][bj][m][1];
                        if (stat) ss += (v0[0] * v0[0] + v0[1] * v0[1]) + (v0[2] * v0[2] + v0[3] * v0[3]) + (v1[0] * v1[0] + v1[1] * v1[1]) + (v1[2] * v1[2] + v1[3] * v1[3]);
                        if (sig) { v0 = fsig4(v0); v1 = fsig4(v1); }
                        *(u32x4*)(rowp + bj * HALF) = pack8(v0, v1); }
                    if (stat) { ss += __shfl_xor(ss, 16); ss += __shfl_xor(ss, 32); if (fq == 0) SSQ[row * 16 + pn * 4 + wc] = ss; } }
        } else if (wc == 0) {
#pragma unroll
            for (int ai = 0; ai < 2; ++ai)
#pragma unroll
                for (int m = 0; m < 4; ++m) { const int row = row0 + ai * HALF + m * 16;
                    const f32x4 c0 = *(const f32x4*)(COS + row * 32 + 8 * fq), c1 = *(const f32x4*)(COS + row * 32 + 8 * fq + 4), s0 = *(const f32x4*)(SIN + row * 32 + 8 * fq), s1 = *(const f32x4*)(SIN + row * 32 + 8 * fq + 4);
                    const f32x4 a0 = acc[ai][0][m][0], a1 = acc[ai][0][m][1], b0 = acc[ai][1][m][0], b1 = acc[ai][1][m][1];
                    *(u32x4*)(KR + (size_t)row * 64 + 8 * fq) = pack8(a0 * c0 - b0 * s0, a1 * c1 - b1 * s1);
                    *(u32x4*)(KR + (size_t)row * 64 + 32 + 8 * fq) = pack8(b0 * c0 + a0 * s0, b1 * c1 + a1 * s1); }
        }
    }
};
__device__ __forceinline__ float row_rs(const float* SSQ, int row, int which) {
    const f32x4 a = *(const f32x4*)(SSQ + row * 16 + which * 8), b = *(const f32x4*)(SSQ + row * 16 + which * 8 + 4);
    const float s = ((a[0] + a[1]) + (a[2] + a[3])) + ((b[0] + b[1]) + (b[2] + b[3]));
    return 1.0f / sqrtf(s * (1.f / 512.f) + RMS_EPS);
}
struct EpiQKV {
    static constexpr bool PERM = true;
    bf16_t *KV, *Q; const float *SSQ, *COS, *SIN;
    __device__ __forceinline__ void operator()(const f32x4 (&acc)[2][2][4][2], const Unit& u, int wr, int wc, int fr, int fq) const {
        const int pn = u.pn, row0 = u.pm * BM + wr * 64 + fr, cw = wc * 32 + 8 * fq;
#pragma unroll
        for (int ai = 0; ai < 2; ++ai)
#pragma unroll
            for (int m = 0; m < 4; ++m) { const int row = row0 + ai * HALF + m * 16;
                if (pn < 24) {
                    const float rs = pn < 16 ? row_rs(SSQ, row, 1) : row_rs(SSQ, row, 0) * QS;
                    bf16_t* rowp = pn < 16 ? KV + (size_t)row * 4096 + pn * 256 + cw : Q + (size_t)row * 3072 + (pn - 16) * 256 + cw;
#pragma unroll
                    for (int bj = 0; bj < 2; ++bj) *(u32x4*)(rowp + bj * HALF) = pack8(acc[ai][bj][m][0] * rs, acc[ai][bj][m][1] * rs);
                } else {
                    const float rs = row_rs(SSQ, row, 0) * QS; const int head = 4 * (pn - 24) + wc;
                    const f32x4 c0 = *(const f32x4*)(COS + row * 32 + 8 * fq), c1 = *(const f32x4*)(COS + row * 32 + 8 * fq + 4), s0 = *(const f32x4*)(SIN + row * 32 + 8 * fq), s1 = *(const f32x4*)(SIN + row * 32 + 8 * fq + 4);
                    const f32x4 a0 = acc[ai][0][m][0] * rs, a1 = acc[ai][0][m][1] * rs, b0 = acc[ai][1][m][0] * rs, b1 = acc[ai][1][m][1] * rs;
                    bf16_t* rowp = Q + (size_t)row * 3072 + 2048 + head * 64 + 8 * fq;
                    *(u32x4*)(rowp) = pack8(a0 * c0 - b0 * s0, a1 * c1 - b1 * s1);
                    *(u32x4*)(rowp + 32) = pack8(b0 * c0 + a0 * s0, b1 * c1 + a1 * s1);
                } }
    }
};
struct EpiMerge {
    static constexpr bool PERM = true;
    bf16_t* MG; const bf16_t* SG;
    __device__ __forceinline__ void operator()(const f32x4 (&acc)[2][2][4][2], const Unit& u, int wr, int wc, int fr, int fq) const {
        const int row0 = u.pm * BM + wr * 64 + fr, col0 = u.pn * BM + wc * 32 + 8 * fq; const bf16_t* sg = SG + (u.flag ? (size_t)M * D : 0);
#pragma unroll
        for (int ai = 0; ai < 2; ++ai)
#pragma unroll
            for (int m = 0; m < 4; ++m) { const size_t off = (size_t)(row0 + ai * HALF + m * 16) * D + col0;
#pragma unroll
                for (int bj = 0; bj < 2; ++bj) { f32x4 g0, g1; unpack8(*(const u32x4*)(sg + off + bj * HALF), g0, g1);
                    f32x4 v0 = acc[ai][bj][m][0] * g0, v1 = acc[ai][bj][m][1] * g1;
                    if (u.flag) { f32x4 p0, p1; unpack8(*(const u32x4*)(MG + off + bj * HALF), p0, p1); v0 += p0; v1 += p1; }
                    *(u32x4*)(MG + off + bj * HALF) = pack8(v0, v1); } }
    }
};
struct EpiPre {
    static constexpr bool PERM = false;
    const float* base; float* out; const float* gate;
    __device__ __forceinline__ void operator()(const f32x4 (&acc)[2][2][4][2], const Unit& u, int wr, int wc, int fr, int fq) const {
        const int row0 = u.pm * BM + wr * 64 + fr, col0 = u.pn * BM + wc * 32 + 4 * fq; const float* gr = gate + (size_t)((u.pm * BM) / SEQ) * NMOD + col0;
        f32x4 gv[2][2];
#pragma unroll
        for (int bj = 0; bj < 2; ++bj)
#pragma unroll
            for (int n = 0; n < 2; ++n) gv[bj][n] = *(const f32x4*)(gr + bj * HALF + n * 16);
#pragma unroll
        for (int ai = 0; ai < 2; ++ai)
#pragma unroll
            for (int m = 0; m < 4; ++m) { const size_t off = (size_t)(row0 + ai * HALF + m * 16) * D + col0;
#pragma unroll
                for (int bj = 0; bj < 2; ++bj)
#pragma unroll
                    for (int n = 0; n < 2; ++n) { const f32x4 bs = *(const f32x4*)(base + off + bj * HALF + n * 16); *(f32x4*)(out + off + bj * HALF + n * 16) = bs * ALPHA + gv[bj][n] * acc[ai][bj][m][n]; }
                if (m & 1) asm volatile("" ::: "memory"); }
    }
};
struct EpiAct {
    static constexpr bool PERM = true;
    bf16_t* ACT;
    __device__ __forceinline__ void operator()(const f32x4 (&acc)[2][2][4][2], const Unit& u, int wr, int wc, int fr, int fq) const {
        const int row0 = u.pm * BM + wr * 64 + fr, col0 = u.pn * HALF + wc * 32 + 8 * fq;
#pragma unroll
        for (int ai = 0; ai < 2; ++ai)
#pragma unroll
            for (int m = 0; m < 4; ++m) { const f32x4 g0 = acc[ai][0][m][0], g1 = acc[ai][0][m][1];
                *(u32x4*)(ACT + (size_t)(row0 + ai * HALF + m * 16) * DFF + col0) = pack8(g0 * fsig4(g0) * acc[ai][1][m][0], g1 * fsig4(g1) * acc[ai][1][m][1]); }
    }
};

template <class Epi, bool ALIGN_EPI>
__device__ __forceinline__ void gemm_phase(PG8_LAS unsigned char* lds, const int K, const int lda, const int ldb, const Sched& S, const Epi& E) {
    const int tid = threadIdx.x, wid = __builtin_amdgcn_readfirstlane(tid >> 6), lane = tid & 63, wr = wid >> 2, wc = wid & 3, fr = lane & 15, fq = lane >> 4;
    const int nt = K / BK;
    unsigned voffA[2], voffB[2];
#pragma unroll
    for (int i = 0; i < 2; ++i) { int R, C; stage_rc(tid * 16 + i * 8192, R, C); const int Rb = Epi::PERM ? ((R & ~31) + perm32(R & 31)) : R;
        voffA[i] = (unsigned)(R * lda + C) * 2u; voffB[i] = (unsigned)(Rb * ldb + C) * 2u; }
    const size_t kstep = (size_t)(BK * 2);
    const size_t hstepA = (size_t)HALF * lda * 2, hstepB = (size_t)HALF * ldb * 2;
    const unsigned ldsw = (unsigned)wid * 1024u;
    const int aoff = lds_byte(wr * 64 + fr, fq * 8), boff = lds_byte(wc * 32 + fr, fq * 8);
#define PG8_SA(b, h) (((b) * 2 + (h)) * HTB)
#define PG8_SB(b, h) ((4 + (b) * 2 + (h)) * HTB)
#define PG8_STAGE(bufoff, gbase, voff) do { _Pragma("unroll") for (int _i = 0; _i < 2; ++_i) \
        __builtin_amdgcn_global_load_lds((const unsigned*)((const char*)(gbase) + (voff)[_i]), (PG8_LAS unsigned*)(lds + (bufoff) + ldsw + _i * 8192), 16, 0, 0); } while (0)
#define PG8_LDA(dst, b, h) do { _Pragma("unroll") for (int m = 0; m < 4; ++m) _Pragma("unroll") for (int k = 0; k < 2; ++k) dst[m][k] = *(const PG8_LAS bf16x8*)(lds + PG8_SA(b, h) + aoff + m * 2048 + k * 1024); } while (0)
#define PG8_LDB(dst, b, h) do { _Pragma("unroll") for (int n = 0; n < 2; ++n) _Pragma("unroll") for (int k = 0; k < 2; ++k) dst[n][k] = *(const PG8_LAS bf16x8*)(lds + PG8_SB(b, h) + boff + n * 2048 + k * 1024); } while (0)
#define PG8_MMA(ai, bj, At, Bt) do { __builtin_amdgcn_s_setprio(1); _Pragma("unroll") for (int m = 0; m < 4; ++m) _Pragma("unroll") for (int n = 0; n < 2; ++n) _Pragma("unroll") for (int k = 0; k < 2; ++k) \
        acc[ai][bj][m][n] = __builtin_amdgcn_mfma_f32_16x16x32_bf16(Bt[n][k], At[m][k], acc[ai][bj][m][n], 0, 0, 0); __builtin_amdgcn_s_setprio(0); } while (0)
#define PG8_WAIT_V(n) asm volatile("s_waitcnt vmcnt(" #n ")" ::: "memory")
#define PG8_WAIT_L(n) asm volatile("s_waitcnt lgkmcnt(" #n ")" ::: "memory")
#define PG8_BAR __builtin_amdgcn_s_barrier()
#define PG8_SCHED __builtin_amdgcn_sched_barrier(0)
    Unit cur, nxt; int ui = 0;
    if (!S.next(0, cur)) return;
    f32x4 acc[2][2][4][2];
#pragma unroll
    for (int a = 0; a < 2; ++a)
#pragma unroll
        for (int b = 0; b < 2; ++b)
#pragma unroll
            for (int m = 0; m < 4; ++m)
#pragma unroll
                for (int n = 0; n < 2; ++n) acc[a][b][m][n] = (f32x4){0.f, 0.f, 0.f, 0.f};
    bf16x8 At[4][2], B0[2][2], B1[2][2];
    const char* cA = cur.A; const char* cB = cur.B;
    PG8_STAGE(PG8_SB(0, 0), cB, voffB); PG8_STAGE(PG8_SB(0, 1), cB + hstepB, voffB); PG8_STAGE(PG8_SA(0, 0), cA, voffA); PG8_STAGE(PG8_SA(0, 1), cA + hstepA, voffA);
    if (wr == 1) PG8_BAR;
    PG8_WAIT_V(2); PG8_BAR;
    PG8_STAGE(PG8_SB(1, 0), cB + kstep, voffB); PG8_STAGE(PG8_SA(1, 0), cA + kstep, voffA); PG8_STAGE(PG8_SB(1, 1), cB + hstepB + kstep, voffB);
    PG8_WAIT_V(6); PG8_BAR;
    for (;;) {
        const bool has_next = S.next(ui + 1, nxt);
        const char* nA = has_next ? nxt.A : cA; const char* nB = has_next ? nxt.B : cB;
        for (int t = 0; t < nt; t += 2) {
            const bool last = (t == nt - 2);
            const char* a1 = cA + (size_t)(t + 1) * kstep;
            const char* a2 = last ? nA : cA + (size_t)(t + 2) * kstep; const char* b2 = last ? nB : cB + (size_t)(t + 2) * kstep;
            const char* a3 = a2 + kstep; const char* b3 = b2 + kstep;
            PG8_LDB(B0, 0, 0); PG8_LDB(B1, 0, 1); PG8_SCHED; PG8_LDA(At, 0, 0); PG8_STAGE(PG8_SA(1, 1), a1 + hstepA, voffA);
            PG8_WAIT_V(8); PG8_WAIT_L(0); PG8_BAR; PG8_MMA(0, 0, At, B0); PG8_MMA(0, 1, At, B1); PG8_BAR; PG8_SCHED;
            PG8_LDA(At, 0, 1); PG8_STAGE(PG8_SB(0, 0), b2, voffB); PG8_STAGE(PG8_SB(0, 1), b2 + hstepB, voffB); PG8_STAGE(PG8_SA(0, 0), a2, voffA);
            PG8_WAIT_V(8); PG8_WAIT_L(0); PG8_BAR; PG8_MMA(1, 0, At, B0); PG8_MMA(1, 1, At, B1); PG8_BAR; PG8_SCHED;
            PG8_LDB(B0, 1, 0); PG8_LDB(B1, 1, 1); PG8_SCHED; PG8_LDA(At, 1, 0); PG8_STAGE(PG8_SA(0, 1), a2 + hstepA, voffA);
            PG8_WAIT_V(8); PG8_WAIT_L(0); PG8_BAR; PG8_MMA(0, 0, At, B0); PG8_MMA(0, 1, At, B1); PG8_BAR; PG8_SCHED;
            PG8_LDA(At, 1, 1); PG8_STAGE(PG8_SB(1, 0), b3, voffB); PG8_STAGE(PG8_SB(1, 1), b3 + hstepB, voffB); PG8_STAGE(PG8_SA(1, 0), a3, voffA);
            PG8_WAIT_V(8); PG8_WAIT_L(0); PG8_BAR; PG8_MMA(1, 0, At, B0); PG8_MMA(1, 1, At, B1); PG8_BAR; PG8_SCHED;
        }
        if constexpr (ALIGN_EPI) { if (wr == 0) PG8_BAR; }
        E(acc, cur, wr, wc, fr, fq);
        if (!has_next) break;
#pragma unroll
        for (int a = 0; a < 2; ++a)
#pragma unroll
            for (int b = 0; b < 2; ++b)
#pragma unroll
                for (int m = 0; m < 4; ++m)
#pragma unroll
                    for (int n = 0; n < 2; ++n) acc[a][b][m][n] = (f32x4){0.f, 0.f, 0.f, 0.f};
        cur = nxt; cA = nA; cB = nB; ++ui;
        if constexpr (ALIGN_EPI) { if (wr == 1) PG8_BAR; }
    }
    PG8_WAIT_V(0);
    if constexpr (!ALIGN_EPI) { if (wr == 0) PG8_BAR; }
    PG8_BAR;
#undef PG8_SA
#undef PG8_SB
#undef PG8_STAGE
#undef PG8_LDA
#undef PG8_LDB
#undef PG8_MMA
#undef PG8_WAIT_V
#undef PG8_WAIT_L
#undef PG8_BAR
#undef PG8_SCHED
}
}

namespace att {
typedef short bf16x8 __attribute__((ext_vector_type(8)));
typedef short s16x4 __attribute__((ext_vector_type(4)));
typedef float f32x16 __attribute__((ext_vector_type(16)));
typedef unsigned u32x4 __attribute__((ext_vector_type(4)));
typedef __attribute__((address_space(3))) unsigned char* lptr;
constexpr int KN_B = 64 * 256, KR_B = 64 * 128, V_B = 64 * 256, BUF_B = KN_B + KR_B + V_B;
constexpr int OFF_KN = 0, OFF_KR = KN_B, OFF_V = KN_B + KR_B, OFF_WS = 2 * BUF_B, OFF_QR = OFF_WS + 8 * 64 * 4, LDS_BYTES = OFF_QR + 8 * 4096;
#define ATT_SBAR() __builtin_amdgcn_sched_barrier(0)
__device__ __forceinline__ int v_st(int k, int c) { const int kk = (k & ~0xC) | ((k & 4) << 1) | ((k & 8) >> 1); return ((kk >> 3) * 4 + (c >> 5)) * 512 + ((kk & 7) * 32 + (c & 31)) * 2; }
__device__ __forceinline__ int v_rd_base(int lane) { return ((lane & 3) << 3) | (((lane >> 2) & 3) << 6) | (((lane >> 4) & 1) << 5) | (((lane >> 5) & 1) << 8); }
constexpr int v_rd_off(int d0, int ks, int half) { return d0 * 512 + ks * 4096 + half * 2048; }
__device__ __forceinline__ int crow(int r, int hi) { return (r & 3) + 8 * (r >> 2) + 4 * hi; }
__device__ __forceinline__ unsigned cvtpk(float lo, float hi) { unsigned r; asm volatile("v_cvt_pk_bf16_f32 %0, %1, %2" : "=v"(r) : "v"(lo), "v"(hi)); return r; }

__device__ __forceinline__ void partialSM(f32x16& p0, f32x16& p1, float& m_reg, float& alpha) {
    float pmax = p0[0];
#pragma unroll
    for (int r = 1; r < 16; ++r) pmax = fmaxf(pmax, p0[r]);
#pragma unroll
    for (int r = 0; r < 16; ++r) pmax = fmaxf(pmax, p1[r]);
    { auto rr = __builtin_amdgcn_permlane32_swap(__float_as_uint(pmax), __float_as_uint(pmax), false, false); pmax = fmaxf(__uint_as_float(rr[0]), __uint_as_float(rr[1])); }
    float mn;
    if (__builtin_expect(__all(pmax <= m_reg), 0)) { mn = m_reg; alpha = 1.f; }
    else { mn = fmaxf(m_reg, pmax); alpha = __builtin_amdgcn_exp2f(m_reg - mn); m_reg = mn; }
#pragma unroll
    for (int r = 0; r < 16; ++r) { p0[r] = __builtin_amdgcn_exp2f(p0[r] - mn); p1[r] = __builtin_amdgcn_exp2f(p1[r] - mn); }
}
__device__ __forceinline__ void finishSM(f32x16& p0, f32x16& p1, float alpha, float& l_reg, bf16x8& pa0, bf16x8& pa1, bf16x8& pa2, bf16x8& pa3) {
    float ps = 0.f;
#pragma unroll
    for (int r = 0; r < 16; ++r) ps += p0[r];
#pragma unroll
    for (int r = 0; r < 16; ++r) ps += p1[r];
    { auto rr = __builtin_amdgcn_permlane32_swap(__float_as_uint(ps), __float_as_uint(ps), false, false); ps = __uint_as_float(rr[0]) + __uint_as_float(rr[1]); }
    l_reg = l_reg * alpha + ps;
#define ATT_PK4(P, B_, OUT) do { unsigned a0 = cvtpk(P[B_ + 0], P[B_ + 1]), a1 = cvtpk(P[B_ + 2], P[B_ + 3]); unsigned b0 = cvtpk(P[B_ + 4], P[B_ + 5]), b1 = cvtpk(P[B_ + 6], P[B_ + 7]); \
        auto r0 = __builtin_amdgcn_permlane32_swap(a0, b0, false, false); auto r1 = __builtin_amdgcn_permlane32_swap(a1, b1, false, false); \
        u32x4 w = {r0[0], r1[0], r0[1], r1[1]}; OUT = __builtin_bit_cast(bf16x8, w); } while (0)
    ATT_PK4(p0, 0, pa0); ATT_PK4(p0, 8, pa1); ATT_PK4(p1, 0, pa2); ATT_PK4(p1, 8, pa3);
#undef ATT_PK4
}
template <int KB>
__device__ __forceinline__ void qkt(f32x16& p0, f32x16& p1, lptr lds, int r32, int hi, const bf16x8* qr, lptr qsp) {
    p0 = f32x16{}; p1 = f32x16{};
    const lptr kn = lds + KB * BUF_B + OFF_KN + r32 * 256, kr = lds + KB * BUF_B + OFF_KR + r32 * 128;
    const int sw = (r32 & 7) << 4, sw2 = (r32 >> 1) & 7;
#pragma unroll
    for (int d0 = 0; d0 < 8; ++d0) { const int cb = ((2 * d0 + hi) * 16) ^ sw;
        const bf16x8 b0 = *(const __attribute__((address_space(3))) bf16x8*)(kn + cb);
        const bf16x8 b1 = *(const __attribute__((address_space(3))) bf16x8*)(kn + cb + 32 * 256);
        p0 = __builtin_amdgcn_mfma_f32_32x32x16_bf16(b0, qr[d0], p0, 0, 0, 0);
        p1 = __builtin_amdgcn_mfma_f32_32x32x16_bf16(b1, qr[d0], p1, 0, 0, 0);
        if ((d0 & 3) == 3) ATT_SBAR(); }
#pragma unroll
    for (int d0 = 0; d0 < 4; ++d0) { const int cb = ((2 * d0 + hi) ^ sw2) << 4;
        const bf16x8 b0 = *(const __attribute__((address_space(3))) bf16x8*)(kr + cb);
        const bf16x8 b1 = *(const __attribute__((address_space(3))) bf16x8*)(kr + cb + 32 * 128);
        const bf16x8 qv = *(const __attribute__((address_space(3))) bf16x8*)(qsp + d0 * 1024);
        p0 = __builtin_amdgcn_mfma_f32_32x32x16_bf16(b0, qv, p0, 0, 0, 0);
        p1 = __builtin_amdgcn_mfma_f32_32x32x16_bf16(b1, qv, p1, 0, 0, 0); }
}
template <int VB>
__device__ __forceinline__ void pv_tile(f32x16* o, int vb0, bf16x8 pa0, bf16x8 pa1, bf16x8 pa2, bf16x8 pa3) {
#define ATT_TRRD(dst, off) asm volatile("ds_read_b64_tr_b16 %0, %1 offset:%2" : "=&v"(dst) : "v"(vb0), "i"(off) : "memory")
#define ATT_PV_D0(d0) do { s16x4 l0, l1, l2, l3, h0, h1, h2, h3; constexpr int b_ = VB * BUF_B + v_rd_off(d0, 0, 0); \
        ATT_TRRD(l0, b_); ATT_TRRD(h0, b_ + 2048); ATT_TRRD(l1, b_ + 4096); ATT_TRRD(h1, b_ + 6144); ATT_TRRD(l2, b_ + 8192); ATT_TRRD(h2, b_ + 10240); ATT_TRRD(l3, b_ + 12288); ATT_TRRD(h3, b_ + 14336); \
        asm volatile("s_waitcnt lgkmcnt(0)" ::: "memory"); ATT_SBAR(); \
        o[d0] = __builtin_amdgcn_mfma_f32_32x32x16_bf16(pa0, (bf16x8){l0[0], l0[1], l0[2], l0[3], h0[0], h0[1], h0[2], h0[3]}, o[d0], 0, 0, 0); \
        o[d0] = __builtin_amdgcn_mfma_f32_32x32x16_bf16(pa1, (bf16x8){l1[0], l1[1], l1[2], l1[3], h1[0], h1[1], h1[2], h1[3]}, o[d0], 0, 0, 0); \
        o[d0] = __builtin_amdgcn_mfma_f32_32x32x16_bf16(pa2, (bf16x8){l2[0], l2[1], l2[2], l2[3], h2[0], h2[1], h2[2], h2[3]}, o[d0], 0, 0, 0); \
        o[d0] = __builtin_amdgcn_mfma_f32_32x32x16_bf16(pa3, (bf16x8){l3[0], l3[1], l3[2], l3[3], h3[0], h3[1], h3[2], h3[3]}, o[d0], 0, 0, 0); } while (0)
    ATT_PV_D0(0); ATT_PV_D0(1); ATT_PV_D0(2); ATT_PV_D0(3);
#undef ATT_PV_D0
#undef ATT_TRRD
}
__device__ __forceinline__ void attn_unit(int b, int h, int qb, const bf16_t* __restrict__ Q, const bf16_t* __restrict__ KV, const bf16_t* __restrict__ KR, bf16_t* __restrict__ O, lptr lds) {
    const int tid = threadIdx.x, wid = __builtin_amdgcn_readfirstlane(tid >> 6), lane = tid & 63, r32 = lane & 31, hi = lane >> 5;
    const size_t rowb = (size_t)b * SEQ;
    const int q0 = qb * 256 + wid * 32;
    const int NT = 4 * (qb + 1), wlast = 4 * qb + (wid >> 1);
    const int sr = tid >> 4, sc = (tid & 15) * 8;
    const int rr = tid >> 3, rc = tid & 7;
    const int kws = sr * 256 + ((sc * 2) ^ ((sr & 7) << 4)), krs = rr * 128 + ((rc ^ ((rr >> 1) & 7)) << 4), vst0 = v_st(sr, sc), vst1 = v_st(32 + sr, sc);
    const bf16_t* kvsrc = KV + (rowb + sr) * 4096 + h * 256 + sc;
    const bf16_t* krsrc = KR + (rowb + rr) * 64 + rc * 8;
    const int vb0 = (int)(unsigned)(uintptr_t)lds + OFF_V + v_rd_base(lane);
    __attribute__((address_space(3))) float* wsf = (__attribute__((address_space(3))) float*)(lds + OFF_WS) + wid * 64;
    bf16x8 qr[8];
    const lptr qsp = lds + OFF_QR + wid * 4096 + lane * 16;
    { const bf16_t* qrow = Q + (rowb + q0 + r32) * 3072;
#pragma unroll
      for (int d0 = 0; d0 < 8; ++d0) qr[d0] = *(const bf16x8*)(qrow + h * 128 + d0 * 16 + hi * 8);
#pragma unroll
      for (int d0 = 0; d0 < 4; ++d0) *(__attribute__((address_space(3))) bf16x8*)(qsp + d0 * 1024) = *(const bf16x8*)(qrow + 2048 + h * 64 + d0 * 16 + hi * 8); }
    float m_reg = -1e30f, l_reg = 0.f; f32x16 o[4] = {};
    bf16x8 st_k0, st_k1, st_v0, st_v1, st_r;
#define ATT_SLOAD(t) do { const size_t ko = (size_t)(t) * 64 * 4096; st_k0 = *(const bf16x8*)(kvsrc + ko); st_k1 = *(const bf16x8*)(kvsrc + ko + 32 * 4096); \
        st_v0 = *(const bf16x8*)(kvsrc + ko + 128); st_v1 = *(const bf16x8*)(kvsrc + ko + 32 * 4096 + 128); st_r = *(const bf16x8*)(krsrc + (size_t)(t) * 64 * 64); } while (0)
#define ATT_SWRITE(bf) do { const lptr bb = lds + (bf) * BUF_B; *(__attribute__((address_space(3))) bf16x8*)(bb + OFF_KN + kws) = st_k0; *(__attribute__((address_space(3))) bf16x8*)(bb + OFF_KN + kws + 32 * 256) = st_k1; \
        *(__attribute__((address_space(3))) bf16x8*)(bb + OFF_V + vst0) = st_v0; *(__attribute__((address_space(3))) bf16x8*)(bb + OFF_V + vst1) = st_v1; *(__attribute__((address_space(3))) bf16x8*)(bb + OFF_KR + krs) = st_r; } while (0)
#define ATT_TILE(KB) do { f32x16 p0, p1; float alpha; bf16x8 pa0, pa1, pa2, pa3; \
        qkt<KB>(p0, p1, lds, r32, hi, qr, qsp); partialSM(p0, p1, m_reg, alpha); \
        if (__any(alpha < 1.f)) { if (hi == 0) wsf[32 + r32] = alpha; asm volatile("s_waitcnt lgkmcnt(0)" ::: "memory"); \
            _Pragma("unroll") for (int d_ = 0; d_ < 4; ++d_) _Pragma("unroll") for (int r = 0; r < 16; ++r) o[d_][r] *= wsf[32 + crow(r, hi)]; } \
        finishSM(p0, p1, alpha, l_reg, pa0, pa1, pa2, pa3); ATT_SBAR(); pv_tile<KB>(o, vb0, pa0, pa1, pa2, pa3); } while (0)
    ATT_SLOAD(0); ATT_SWRITE(0); __syncthreads();
    for (int t = 0; t < NT; t += 2) {
        ATT_SLOAD(t + 1);
        if (t <= wlast) ATT_TILE(0);
        ATT_SWRITE(1); __syncthreads();
        if (t + 2 < NT) ATT_SLOAD(t + 2);
        if (t + 1 <= wlast) ATT_TILE(1);
        if (t + 2 < NT) ATT_SWRITE(0);
        __syncthreads();
    }
    if (hi == 0) wsf[r32] = l_reg; asm volatile("s_waitcnt lgkmcnt(0)" ::: "memory");
    int ecol = r32, ehi = hi; asm volatile("" : "+v"(ecol), "+v"(ehi));
    bf16_t* Ow = O + (rowb + q0 + 4 * ehi) * D + h * 128 + ecol;
#pragma unroll
    for (int r = 0; r < 16; ++r) { const int orow = (r & 3) + 8 * (r >> 2); const float rl = __builtin_amdgcn_rcpf(wsf[orow + 4 * ehi]);
#pragma unroll
        for (int d0 = 0; d0 < 4; ++d0) { const float v = o[d0][r] * rl; const float vn = __shfl_xor(v, 1);
            if ((r32 & 1) == 0) *(unsigned*)(Ow + (size_t)orow * D + d0 * 32) = cvtpk(v, vn); } }
    __syncthreads();
#undef ATT_SLOAD
#undef ATT_SWRITE
#undef ATT_TILE
}
#undef ATT_SBAR
}

#define GAS __attribute__((address_space(1)))
#define LAS __attribute__((address_space(3)))
typedef unsigned v4u __attribute__((ext_vector_type(4)));
typedef float f32x4 __attribute__((ext_vector_type(4)));
typedef GAS unsigned gu32;
constexpr int NWAVES = 8, NPHASE = 11;
constexpr int RING_OFF = 0, RING_BYTES = 131072, LDSCTL_OFF = RING_BYTES, MISC_OFF = LDSCTL_OFF + 320, LDS_BYTES = 147456;
constexpr int CW_BAR = 4096;
constexpr size_t WO_WIN = 0, WO_WKVQ = 45 * MiB, WO_WOA = 52 * MiB, WO_WOB = 60 * MiB, WO_WO = 68 * MiB, WO_WFOUT = 0;
constexpr int NWIN = 11520;
#define LDS_WAIT() asm volatile("s_waitcnt lgkmcnt(0)" ::: "memory")
__device__ __forceinline__ unsigned pk2(float lo, float hi) { return f2bf(lo) | (f2bf(hi) << 16); }

#define XB_TMO      128
#define XB_XCNT(j)  (256  + 64 * (j))
#define XB_XSUB(j)  (1280 + 64 * (j))
#define XB_XGEN(j)  (2304 + 64 * (j))
#define XB_TOP      3328
#define XB_TOPGEN   3392
#define XCD_BAR_WORDS 3456
#define XB_SPIN_CAP (1u << 18)
__device__ __forceinline__ unsigned xb_ld(unsigned* p)              { return __hip_atomic_load(p, __ATOMIC_RELAXED, __HIP_MEMORY_SCOPE_AGENT); }
__device__ __forceinline__ unsigned xb_add(unsigned* p, unsigned v) { return __hip_atomic_fetch_add(p, v, __ATOMIC_RELAXED, __HIP_MEMORY_SCOPE_AGENT); }
__device__ __forceinline__ unsigned xb_xcc_id() { return (unsigned)__builtin_amdgcn_s_getreg((3 << 11) | 20) & 0xFu; }
#define XB_SPIN(cond, bar) do { unsigned _sp = 0; while (cond) { __builtin_amdgcn_s_sleep(1); \
    if ((++_sp & 255u) == 0u) { if (xb_ld(&(bar)[XB_TMO])) break; if (_sp > XB_SPIN_CAP) { atomicAdd(&(bar)[XB_TMO], 1u); break; } } } } while (0)
struct XcdBarrier { unsigned* bar; unsigned x; volatile LAS unsigned* st; };
__device__ __forceinline__ XcdBarrier xcd_barrier_post(unsigned* bar, volatile LAS unsigned* st) {
    XcdBarrier b; b.bar = bar; b.x = xb_xcc_id(); b.st = st;
    if (threadIdx.x == 0) (void)xb_add(&bar[XB_XCNT(b.x)], 1u);
    return b;
}
__device__ __forceinline__ void xcd_barrier_complete(unsigned* bar, unsigned x, unsigned& nloc, unsigned& nx) {
    const unsigned G = gridDim.x * gridDim.y * gridDim.z;
    unsigned sum, cnt, mine, sp = 0u;
    for (;;) {
        sum = 0u; cnt = 0u; mine = 0u;
#pragma unroll
        for (unsigned j = 0; j < 16; ++j) { const unsigned c = xb_ld(&bar[XB_XCNT(j)]); sum += c; cnt += (c > 0u) ? 1u : 0u; mine = (j == x) ? c : mine; }
        if (sum == G) break;
        __builtin_amdgcn_s_sleep(1);
        if ((++sp & 255u) == 0u) { if (xb_ld(&bar[XB_TMO])) break; if (sp > XB_SPIN_CAP) { atomicAdd(&bar[XB_TMO], 1u); break; } }
    }
    nloc = mine > 0u ? mine : 1u; nx = cnt > 0u ? cnt : 1u;
}
__device__ __forceinline__ void xcd_barrier(const XcdBarrier& b) {
    asm volatile("s_waitcnt vmcnt(0)" ::: "memory");
    __syncthreads();
    if (threadIdx.x == 0) {
        unsigned* bar = b.bar;
        __builtin_amdgcn_s_waitcnt(0);
        unsigned nloc = b.st[0], nx = b.st[1];
        if (nloc == 0u) { xcd_barrier_complete(bar, b.x, nloc, nx); b.st[0] = nloc; b.st[1] = nx; }
        const unsigned old = xb_add(&bar[XB_XSUB(b.x)], 1u);
        const unsigned gen = old / nloc;
        if (old + 1u == (gen + 1u) * nloc) {
            __builtin_amdgcn_fence(__ATOMIC_RELEASE, "agent");
            asm volatile("s_waitcnt vmcnt(0)" ::: "memory");
            const unsigned og = xb_add(&bar[XB_TOP], 1u);
            const unsigned tg = og / nx;
            if (og + 1u == (tg + 1u) * nx) xb_add(&bar[XB_TOPGEN], 1u);
            else XB_SPIN(xb_ld(&bar[XB_TOPGEN]) == tg, bar);
            __builtin_amdgcn_fence(__ATOMIC_ACQUIRE, "agent");
            xb_add(&bar[XB_XGEN(b.x)], 1u);
            asm volatile("s_waitcnt vmcnt(0)" ::: "memory");
        } else {
            XB_SPIN(xb_ld(&bar[XB_XGEN(b.x)]) == gen, bar);
            __builtin_amdgcn_fence(__ATOMIC_ACQUIRE, "agent");
            asm volatile("s_waitcnt vmcnt(0)" ::: "memory");
        }
    }
    __syncthreads();
}

__device__ __forceinline__ float wave_sum(float v) {
#pragma unroll
    for (int o = 1; o < 64; o <<= 1) v += __shfl_xor(v, o);
    return v;
}
__device__ __forceinline__ int map_win(int nb) { const int s = nb * 32;
    if (s < 1024) return s; if (s < 1088) return 11264 + 128 * (nb - 32);
    if (s >= 3136 && s < 5184) { const int c = s - 3136; return 3072 + (c >> 7) * 256 + (c & 127); }
    if (s >= 5184 && s < 7232) { const int c = s - 5184; return 3072 + (c >> 7) * 256 + 128 + (c & 127); }
    return s - 64; }
__device__ __forceinline__ int map_qb(int nb) { const int s = nb * 32, h = s / 192, r = s % 192; if (r < 128) return 4096 + h * 128 + r; return 4096 + 2048 + (h >> 2) * 256 + ((r - 128) >> 5) * 128 + (h & 3) * 32; }
__device__ __forceinline__ int map_fin(int nb) { int s = nb * 32; if (s < DFF) return (s >> 7) * 256 + (s & 127); s -= DFF; return (s >> 7) * 256 + 128 + (s & 127); }
struct TrJob { const float* W; bf16_t* WT; const float* ks; int K, N, nbn, mapkind; };
__device__ __forceinline__ void tr_load(const TrJob& J, int it, int lane, f32x4 (&wv)[16]) {
    const int kb = it / J.nbn, nb = it - kb * J.nbn; const float* wp = J.W + (size_t)(kb * 64 + (lane >> 4)) * J.N + nb * 64 + (lane & 15) * 4;
#pragma unroll
    for (int i = 0; i < 16; ++i) wv[i] = *(const f32x4*)(wp + (size_t)(4 * i) * J.N);
}
__device__ __forceinline__ void tr_store(const TrJob& J, int it, int lane, const f32x4 (&wv)[16], LAS float* scr) {
    const int kb = it / J.nbn, nb = it - kb * J.nbn, k0 = kb * 64, lr = lane >> 4, n4 = (lane & 15) * 4;
    int d0, d1;
    if (J.mapkind == 1) { d0 = map_win(2 * nb); d1 = map_win(2 * nb + 1); } else if (J.mapkind == 2) { d0 = map_qb(2 * nb); d1 = map_qb(2 * nb + 1); }
    else if (J.mapkind == 3) { d0 = map_fin(2 * nb); d1 = map_fin(2 * nb + 1); } else { d0 = nb * 64; d1 = d0 + 32; }
#pragma unroll
    for (int i = 0; i < 16; ++i) { const int kk = 4 * i + lr; f32x4 w = wv[i]; if (J.ks) w = w * J.ks[k0 + kk];
        *(LAS f32x4*)(scr + kk * 64 + (n4 ^ (4 * (kk >> 3)))) = w; }
    LDS_WAIT(); asm volatile("" ::: "memory");
    const int c = lane & 7;
#pragma unroll
    for (int j = 0; j < 8; ++j) { const int n = (lane >> 3) + 8 * j; const LAS float* s = scr + (8 * c) * 64 + (n ^ (4 * c));
        v4u o; o.x = pg8::cvt_pk_bf16(s[0 * 64], s[1 * 64]); o.y = pg8::cvt_pk_bf16(s[2 * 64], s[3 * 64]); o.z = pg8::cvt_pk_bf16(s[4 * 64], s[5 * 64]); o.w = pg8::cvt_pk_bf16(s[6 * 64], s[7 * 64]);
        *(GAS v4u*)(J.WT + (size_t)((n < 32 ? d0 : d1) + (n & 31)) * J.K + k0 + 8 * c) = o; }
    LDS_WAIT(); asm volatile("" ::: "memory");
}
__device__ __forceinline__ void tr_run(const TrJob& J, int first, int end, int step, int lane, LAS float* scr) {
    if (first >= end) return;
    f32x4 A[16], B[16];
    tr_load(J, first, lane, A);
    for (int it = first;; it += 2 * step) {
        const bool h1 = it + step < end;
        if (h1) tr_load(J, it + step, lane, B);
        tr_store(J, it, lane, A, scr);
        if (!h1) break;
        const bool h2 = it + 2 * step < end;
        if (h2) tr_load(J, it + 2 * step, lane, A);
        tr_store(J, it + step, lane, B, scr);
        if (!h2) break;
    }
}

struct Args { const void* in[20]; float* out; unsigned char* ws; int ph_lo, ph_hi; };

__device__ __forceinline__ void gemv_item(const float* __restrict__ w_ada, const float* __restrict__ cvec, float* __restrict__ MODP, int slab, int cg, int lane) {
    const int c0 = cg * 256 + lane * 4, k0 = slab * 128;
    f32x4 a0 = {0.f, 0.f, 0.f, 0.f}, a1 = a0, a2 = a0, a3 = a0;
#pragma unroll 16
    for (int k = 0; k < 128; ++k) { const f32x4 w = *(const f32x4*)(w_ada + (size_t)(k0 + k) * NMOD + c0);
        const float v0 = cvec[k0 + k], v1 = cvec[D + k0 + k], v2 = cvec[2 * D + k0 + k], v3 = cvec[3 * D + k0 + k];
        a0 += w * (v0 / (1.f + __expf(-v0))); a1 += w * (v1 / (1.f + __expf(-v1))); a2 += w * (v2 / (1.f + __expf(-v2))); a3 += w * (v3 / (1.f + __expf(-v3))); }
    float* dst = MODP + (size_t)(slab * 4) * NMOD + c0;
    *(f32x4*)(dst) = a0; *(f32x4*)(dst + NMOD) = a1; *(f32x4*)(dst + 2 * NMOD) = a2; *(f32x4*)(dst + 3 * NMOD) = a3;
}
constexpr int NI_IN = 32 * 177, NI_KV = 8 * 64, NI_QB = 8 * 48, NI_SQ = 32 * 32, NI_FI = 32 * 176, NI_FO = 88 * 32;
constexpr int NI_FI_P3 = 1536;
static_assert(NI_KV % 128 == 0 && NI_QB % 128 == 0 && NI_SQ % 128 == 0 && NI_FI_P3 % 256 == 0 && NI_FO % 128 == 0, "stream list balance");
__global__ void __launch_bounds__(NWAVES * 64, 2) mega_fwd(Args args) {
    extern __shared__ __attribute__((aligned(16))) unsigned char lds_raw[];
    LAS unsigned char* lds = (LAS unsigned char*)lds_raw;
    volatile LAS unsigned* MISC = (volatile LAS unsigned*)(lds + MISC_OFF);
    const int tid = threadIdx.x, lane = tid & 63, wave = __builtin_amdgcn_readfirstlane(tid >> 6);
    const int G = gridDim.x, bx = blockIdx.x, vcu = (bx % 8) * (G / 8) + bx / 8;
    const int gw = vcu * NWAVES + wave, NGW = G * NWAVES;
    unsigned char* ws = args.ws;
    const float* x = (const float*)args.in[0]; const float* cvec = (const float*)args.in[1]; const int* pos = (const int*)args.in[2];
    const float* w_ada = (const float*)args.in[3]; const float* b_ada = (const float*)args.in[4]; const float* w_in = (const float*)args.in[5];
    const float* g_q = (const float*)args.in[6]; const float* w_qb = (const float*)args.in[7]; const float* g_kv = (const float*)args.in[8]; const float* w_kvb = (const float*)args.in[9];
    const float* w_oa = (const float*)args.in[10]; const float* w_conv = (const float*)args.in[11]; const float* w_ob = (const float*)args.in[12]; const float* w_o = (const float*)args.in[13];
    const float* ln1g = (const float*)args.in[14]; const float* ln1b = (const float*)args.in[15]; const float* w_fi = (const float*)args.in[16]; const float* w_fo = (const float*)args.in[17];
    const float* ln2g = (const float*)args.in[18]; const float* ln2b = (const float*)args.in[19];
    float* out = args.out;
    float* MOD = (float*)(ws + WS_MOD); float* MODP = (float*)(ws + WS_MODP); float* COS = (float*)(ws + WS_COS); float* SIN = (float*)(ws + WS_SIN); float* SSQ = (float*)(ws + WS_SSQ);
    bf16_t* KR = (bf16_t*)(ws + WS_KROPE); bf16_t* A0b = (bf16_t*)(ws + WS_A0);
    bf16_t* QA = (bf16_t*)(ws + WS_QA); bf16_t* KVA = (bf16_t*)(ws + WS_KVA); bf16_t* CB = (bf16_t*)(ws + WS_CB); bf16_t* Zb = (bf16_t*)(ws + WS_Z);
    bf16_t* SGA = (bf16_t*)(ws + WS_SGA); bf16_t* Qb = (bf16_t*)(ws + WS_Q); bf16_t* KVb = (bf16_t*)(ws + WS_KV);
    bf16_t* ATT = CB; bf16_t* ACT = CB; bf16_t* MG = Qb; bf16_t* YB = A0b;
    bf16_t* W_IN = (bf16_t*)(ws + WS_W + WO_WIN); bf16_t* W_KVQ = (bf16_t*)(ws + WS_W + WO_WKVQ); bf16_t* W_OA = (bf16_t*)(ws + WS_W + WO_WOA); bf16_t* W_OB = (bf16_t*)(ws + WS_W + WO_WOB);
    bf16_t* W_O = (bf16_t*)(ws + WS_W + WO_WO); bf16_t* W_FIN = (bf16_t*)(ws + WS_WFIN); bf16_t* W_FOUT = (bf16_t*)(ws + WS_W + WO_WFOUT);

    for (int u = tid; u < (LDS_BYTES - LDSCTL_OFF) / 4; u += NWAVES * 64) ((LAS unsigned*)(lds + LDSCTL_OFF))[u] = 0u;
    __syncthreads();
    const int lo = args.ph_lo, hi = args.ph_hi;
    const bool multi = (hi - lo) > 1;
    XcdBarrier bar; bar.bar = (unsigned*)(ws + WS_CTL) + CW_BAR; bar.x = 0; bar.st = nullptr;
    if (multi) bar = xcd_barrier_post((unsigned*)(ws + WS_CTL) + CW_BAR, MISC + 8);
#define IN(k) (lo <= (k) && (k) < hi)
#define SEAM(k) do { if (multi && IN(k) && IN((k) + 1)) xcd_barrier(bar); } while (0)
    LAS float* scr = (LAS float*)(lds + RING_OFF + wave * 16384);
    const TrJob J_IN{w_in, W_IN, nullptr, D, DIN, DIN / 64, 1}, J_KV{w_kvb, W_KVQ, g_kv, 512, 4096, 64, 0}, J_QB{w_qb, W_KVQ, g_q, 512, 3072, 48, 2};
    const TrJob J_OA{w_oa, W_OA, nullptr, D, D, 32, 0}, J_OB{w_ob, W_OB, nullptr, D, D, 32, 0}, J_O{w_o, W_O, nullptr, D, D, 32, 0};
    const TrJob J_FI{w_fi, W_FIN, nullptr, D, 2 * DFF, 176, 3}, J_FO{w_fo, W_FOUT, nullptr, DFF, D, 32, 0};
    if (IN(0)) {
        if (wave < 3) { const int it = vcu * 3 + wave; gemv_item(w_ada, cvec, MODP, it / 48, it % 48, lane); }
        else tr_run(J_IN, vcu * 5 + (wave - 3), NI_IN, 256 * 5, lane, scr);
        for (int idx = gw * 64 + lane; idx < M * 32; idx += NGW * 64) { const int m = idx >> 5, i = idx & 31;
            const float inv = 1.0f / powf(10000.f, (float)(2 * i) / 64.f); const float ang = (float)pos[m] * inv; COS[idx] = cosf(ang); SIN[idx] = sinf(ang); }
        for (int idx = gw * 64 + lane; idx < 192 * 256; idx += NGW * 64) { const int r = idx >> 8, c = idx & 255; const int row = 11264 + (r < 96 ? 32 + r : 160 + (r - 96));
            *(GAS v4u*)(W_IN + (size_t)row * D + c * 8) = (v4u){0u, 0u, 0u, 0u}; }
        SEAM(0);
    }
    if (IN(1)) {
        const int r0 = vcu * (M / G), b = r0 / SEQ;
        LAS float* sm = (LAS float*)(lds + RING_OFF);
        for (int j = 4 * tid; j < 2 * D; j += 4 * NWAVES * 64) { f32x4 s = *(const f32x4*)(b_ada + j);
#pragma unroll
            for (int sl = 0; sl < 16; ++sl) s += *(const f32x4*)(MODP + (size_t)(sl * 4 + b) * NMOD + j);
            *(LAS f32x4*)(sm + j) = s; }
        for (int idx = vcu * (BATCH * NMOD / G) + 4 * tid; idx < (vcu + 1) * (BATCH * NMOD / G); idx += 4 * NWAVES * 64) { const int bb = idx / NMOD, n = idx % NMOD; f32x4 s = *(const f32x4*)(b_ada + n);
#pragma unroll
            for (int sl = 0; sl < 16; ++sl) s += *(const f32x4*)(MODP + (size_t)(sl * 4 + bb) * NMOD + n);
            *(f32x4*)(MOD + idx) = s; }
        __syncthreads();
        for (int r = wave; r < M / G; r += NWAVES) { const int m = r0 + r; const f32x4* xr = (const f32x4*)(x + (size_t)m * D) + lane; unsigned long long* o8 = (unsigned long long*)(A0b + (size_t)m * D) + lane;
#pragma unroll
            for (int j = 0; j < 8; ++j) { const f32x4 v = xr[64 * j]; const int c = 4 * lane + 256 * j;
                const f32x4 sh = *(const LAS f32x4*)(sm + c), sc = *(const LAS f32x4*)(sm + D + c); const f32x4 y = v * (sc + 1.0f) + sh;
                o8[64 * j] = (unsigned long long)pk2(y[0], y[1]) | ((unsigned long long)pk2(y[2], y[3]) << 32); } }
        __syncthreads();
        SEAM(1);
    }
    if (IN(2)) {
        if (bx < 240) {
            pg8::Sched S{0, M / 256, NWIN / 256, (M / 256) * (NWIN / 256), 240, bx, (const char*)A0b, nullptr, (const char*)W_IN, nullptr, (size_t)256 * D * 2, (size_t)256 * D * 2};
            pg8::EpiProj E{QA, KVA, CB, Zb, SGA, KR, SSQ, COS, SIN};
            pg8::gemm_phase<pg8::EpiProj, true>(lds + RING_OFF, D, D, D, S, E);
        } else { const int sw = (bx - 240) * NWAVES + wave;
            tr_run(J_KV, sw, NI_KV, 128, lane, scr); tr_run(J_QB, sw, NI_QB, 128, lane, scr); tr_run(J_OA, sw, NI_SQ, 128, lane, scr); tr_run(J_OB, sw, NI_SQ, 128, lane, scr); tr_run(J_O, sw, NI_SQ, 128, lane, scr); }
        SEAM(2);
    }
    if (IN(3)) {
        for (int it = gw; it < (M / 16) * 4; it += NGW) { const int rb = it >> 2, c0 = (it & 3) * 512 + lane * 8, m0 = rb * 16;
            f32x4 w0a = *(const f32x4*)(w_conv + c0), w0b = *(const f32x4*)(w_conv + c0 + 4), w1a = *(const f32x4*)(w_conv + D + c0), w1b = *(const f32x4*)(w_conv + D + c0 + 4), w2a = *(const f32x4*)(w_conv + 2 * D + c0), w2b = *(const f32x4*)(w_conv + 2 * D + c0 + 4);
            f32x4 zm2a = {0.f, 0.f, 0.f, 0.f}, zm2b = zm2a, zm1a = zm2a, zm1b = zm2a;
            if ((m0 % SEQ) != 0) { pg8::unpack8(*(const v4u*)(Zb + (size_t)(m0 - 2) * D + c0), zm2a, zm2b); pg8::unpack8(*(const v4u*)(Zb + (size_t)(m0 - 1) * D + c0), zm1a, zm1b); }
#pragma unroll 4
            for (int r = 0; r < 16; ++r) { const size_t o = (size_t)(m0 + r) * D + c0; f32x4 za, zb, ba, bb;
                pg8::unpack8(*(const v4u*)(Zb + o), za, zb); pg8::unpack8(*(const v4u*)(CB + o), ba, bb);
                *(v4u*)(YB + o) = pg8::pack8(ba * (w0a * zm2a + w1a * zm1a + w2a * za), bb * (w0b * zm2b + w1b * zm1b + w2b * zb));
                zm2a = zm1a; zm2b = zm1b; zm1a = za; zm1b = zb; } }
        if (bx < 224) {
            pg8::Sched S{1, M / 256, 28, (M / 256) * 28, 224, bx, (const char*)KVA, (const char*)QA, (const char*)W_KVQ, nullptr, (size_t)256 * 512 * 2, (size_t)256 * 512 * 2};
            pg8::EpiQKV E{KVb, Qb, SSQ, COS, SIN};
            pg8::gemm_phase<pg8::EpiQKV, true>(lds + RING_OFF, 512, 512, 512, S, E);
        } else tr_run(J_FI, (bx - 224) * NWAVES + wave, NI_FI_P3, 256, lane, scr);
        SEAM(3);
    }
    if (IN(4)) {
        for (int uidx = vcu; uidx < BATCH * NH * 4; uidx += G) { const int bh = uidx >> 2, s = uidx & 3;
            for (int pass = 0; pass < 2; ++pass) att::attn_unit(bh / NH, bh % NH, pass ? 7 - s : s, Qb, KVb, KR, ATT, lds + RING_OFF); }
        SEAM(4);
    }
    if (IN(5)) {
        pg8::Sched S{2, M / 256, D / 256, (M / 256) * (D / 256), G, bx, (const char*)ATT, (const char*)YB, (const char*)W_OA, (const char*)W_OB, (size_t)256 * D * 2, (size_t)256 * D * 2};
        pg8::EpiMerge E{MG, SGA};
        pg8::gemm_phase<pg8::EpiMerge, true>(lds + RING_OFF, D, D, D, S, E);
        SEAM(5);
    }
    if (IN(6)) {
        pg8::Sched S{0, M / 256, D / 256, (M / 256) * (D / 256), G, bx, (const char*)MG, nullptr, (const char*)W_O, nullptr, (size_t)256 * D * 2, (size_t)256 * D * 2};
        pg8::EpiPre E{x, out, MOD + 2 * D};
        pg8::gemm_phase<pg8::EpiPre, false>(lds + RING_OFF, D, D, D, S, E);
        SEAM(6);
    }
    if (IN(7)) {
        for (int m = gw; m < M; m += NGW) { const int b = m / SEQ; f32x4* xr = (f32x4*)(out + (size_t)m * D) + lane; f32x4 v[8]; float s = 0.f;
#pragma unroll
            for (int j = 0; j < 8; ++j) { v[j] = xr[64 * j]; s += (v[j][0] + v[j][1]) + (v[j][2] + v[j][3]); }
            const float mean = wave_sum(s) * (1.f / D); float s2 = 0.f;
#pragma unroll
            for (int j = 0; j < 8; ++j) { v[j] = v[j] - mean; s2 += (v[j][0] * v[j][0] + v[j][1] * v[j][1]) + (v[j][2] * v[j][2] + v[j][3] * v[j][3]); }
            const float rstd = 1.f / sqrtf(wave_sum(s2) * (1.f / D) + LN_EPS);
            unsigned long long* o8 = (unsigned long long*)(A0b + (size_t)m * D) + lane;
#pragma unroll
            for (int j = 0; j < 8; ++j) { const int c = 4 * lane + 256 * j; const f32x4 y = v[j] * rstd * *(const f32x4*)(ln1g + c) + *(const f32x4*)(ln1b + c); xr[64 * j] = y;
                const f32x4 u2 = y * (*(const f32x4*)(MOD + (size_t)b * NMOD + 4 * D + c) + 1.0f) + *(const f32x4*)(MOD + (size_t)b * NMOD + 3 * D + c);
                o8[64 * j] = (unsigned long long)pk2(u2[0], u2[1]) | ((unsigned long long)pk2(u2[2], u2[3]) << 32); } }
        tr_run(J_FI, NI_FI_P3 + gw, NI_FI, NGW, lane, scr);
        SEAM(7);
    }
    if (IN(8)) {
        if (bx < 240) {
            pg8::Sched S{0, M / 256, 2 * DFF / 256, (M / 256) * (2 * DFF / 256), 240, bx, (const char*)A0b, nullptr, (const char*)W_FIN, nullptr, (size_t)256 * D * 2, (size_t)256 * D * 2};
            pg8::EpiAct E{ACT};
            pg8::gemm_phase<pg8::EpiAct, true>(lds + RING_OFF, D, D, D, S, E);
        } else tr_run(J_FO, (bx - 240) * NWAVES + wave, NI_FO, 128, lane, scr);
        SEAM(8);
    }
    if (IN(9)) {
        pg8::Sched S{0, M / 256, D / 256, (M / 256) * (D / 256), G, bx, (const char*)ACT, nullptr, (const char*)W_FOUT, nullptr, (size_t)256 * DFF * 2, (size_t)256 * DFF * 2};
        pg8::EpiPre E{out, out, MOD + 5 * D};
        pg8::gemm_phase<pg8::EpiPre, false>(lds + RING_OFF, DFF, DFF, DFF, S, E);
        SEAM(9);
    }
    if (IN(10)) {
        for (int m = gw; m < M; m += NGW) { f32x4* xr = (f32x4*)(out + (size_t)m * D) + lane; f32x4 v[8]; float s = 0.f;
#pragma unroll
            for (int j = 0; j < 8; ++j) { v[j] = xr[64 * j]; s += (v[j][0] + v[j][1]) + (v[j][2] + v[j][3]); }
            const float mean = wave_sum(s) * (1.f / D); float s2 = 0.f;
#pragma unroll
            for (int j = 0; j < 8; ++j) { v[j] = v[j] - mean; s2 += (v[j][0] * v[j][0] + v[j][1] * v[j][1]) + (v[j][2] * v[j][2] + v[j][3] * v[j][3]); }
            const float rstd = 1.f / sqrtf(wave_sum(s2) * (1.f / D) + LN_EPS);
#pragma unroll
            for (int j = 0; j < 8; ++j) { const int c = 4 * lane + 256 * j; xr[64 * j] = v[j] * rstd * *(const f32x4*)(ln2g + c) + *(const f32x4*)(ln2b + c); } }
    }
#undef IN
#undef SEAM
}
#ifndef MK_MODE
#define MK_MODE 0
#endif
#ifndef PROBE_HOST_REP
#define PROBE_HOST_REP -1
#endif
extern "C" void kernel_launch(void* const* d_in, const int* in_sizes, int n_in, void* d_out, int out_size, void* d_ws, size_t ws_size, hipStream_t stream) {
    static int grid = 0;
    if (grid == 0) {
        if (n_in != 20 || in_sizes[0] != M * D || out_size != M * D || ws_size < WS_END) {
            fprintf(stderr, "kernel_launch: unexpected shapes: n_in %d in0 %d out %d ws %zu (need >= %zu)\n", n_in, n_in > 0 ? in_sizes[0] : -1, out_size, ws_size, (size_t)WS_END); grid = -1; return; }
        int dev = 0, cus = 0, per_cu = 0;
        if (hipGetDevice(&dev) != hipSuccess || hipDeviceGetAttribute(&cus, hipDeviceAttributeMultiprocessorCount, dev) != hipSuccess) { fprintf(stderr, "kernel_launch: device query failed\n"); grid = -1; return; }
        if (hipFuncSetAttribute((const void*)mega_fwd, hipFuncAttributeMaxDynamicSharedMemorySize, LDS_BYTES) != hipSuccess) { fprintf(stderr, "kernel_launch: hipFuncSetAttribute failed\n"); grid = -1; return; }
        if (hipOccupancyMaxActiveBlocksPerMultiprocessor(&per_cu, (const void*)mega_fwd, NWAVES * 64, LDS_BYTES) != hipSuccess || per_cu < 1)
            fprintf(stderr, "kernel_launch: note: occupancy query reports %d workgroups per CU\n", per_cu);
        (void)hipGetLastError();
        if (cus != 256) { fprintf(stderr, "kernel_launch: built for a 256-CU device (one workgroup per CU), found %d; nothing launched\n", cus); grid = -1; return; }
        grid = cus;
    }
    if (grid < 0) return;
    (void)hipMemsetAsync((unsigned char*)d_ws + WS_CTL, 0, 1 * MiB, stream);
    Args a{};
    for (int i = 0; i < 20; ++i) a.in[i] = d_in[i];
    a.out = (float*)d_out; a.ws = (unsigned char*)d_ws;
#define LAUNCH_MEGA(lo_, hi_) do { a.ph_lo = (lo_); a.ph_hi = (hi_); hipLaunchKernelGGL(mega_fwd, dim3(grid), dim3(NWAVES * 64), LDS_BYTES, stream, a); } while (0)
    if (MK_MODE == 0) { LAUNCH_MEGA(0, NPHASE); return; }
    for (int p = 0; p < NPHASE; ++p) { LAUNCH_MEGA(p, p + 1); if (p == PROBE_HOST_REP) LAUNCH_MEGA(p, p + 1); }
#undef LAUNCH_MEGA
}
```
